# Optimizing an MI355X kernel written in HIP

```python
import math
import jax, jax.numpy as jnp
from jax import lax
import numpy as np

D_MODEL = 1024
BATCH = 4
SEQ = 8192
DEPTH = 2

GRID_W = 64
CTX_LEN = 256
ROPE_BASE = 10000.0
ROPE_DIM = 64
ROPE_FREQS = ROPE_DIM // 4
NORM_EPS = 1e-6
MASK_VALUE = -1e30

DIFF_HEADS = 4
DIFF_DIM = 64
DIFF_VDIM = 2 * DIFF_DIM
DIFF_QBLOCK = 128

HGRN_HEADS = 4
HGRN_DK = 128
HGRN_DV = 128
HGRN_CHUNK = 64

SWA_Q_HEADS = 8
SWA_KV_HEADS = 2
SWA_GROUP = SWA_Q_HEADS // SWA_KV_HEADS
SWA_DIM = 64
WINDOW = 128
SWA_BLOCK = 128

BRANCH_WIDTH = 512
N_BRANCHES = 3
D_FF = 4 * D_MODEL

SPLIT_SIZES = (DIFF_HEADS * 2 * DIFF_DIM, DIFF_HEADS * 2 * DIFF_DIM, DIFF_HEADS * DIFF_VDIM,
               HGRN_HEADS * HGRN_DK, HGRN_HEADS * HGRN_DK, HGRN_HEADS * HGRN_DK,
               HGRN_HEADS * HGRN_DV, HGRN_HEADS * HGRN_DV,
               SWA_Q_HEADS * SWA_DIM, SWA_KV_HEADS * SWA_DIM, SWA_KV_HEADS * SWA_DIM,
               N_BRANCHES * D_MODEL)
IN_WIDTH = sum(SPLIT_SIZES)

F32 = jnp.float32

kernel_name = "hybrid_diffattn_hgrn2_swa_dit"


def rms_norm(x, g):
    xf = x.astype(F32)
    y = xf * lax.rsqrt(jnp.mean(xf * xf, axis=-1, keepdims=True) + NORM_EPS)
    return (y * g.astype(F32)).astype(x.dtype)


def modulate(h, shift, scale):
    return h * (1.0 + scale) + shift


def axial_rope_tables(n_tokens):
    rows = n_tokens // GRID_W
    row = jnp.repeat(jnp.arange(rows), GRID_W)
    col = jnp.tile(jnp.arange(GRID_W), rows)
    inv_freq = ROPE_BASE ** (-jnp.arange(ROPE_FREQS, dtype=F32) / ROPE_FREQS)
    pos = jnp.stack([row, col], axis=-1).astype(F32)
    ang = pos[:, :, None] * inv_freq
    return jnp.cos(ang), jnp.sin(ang)


def apply_axial_rope(x, cos, sin):
    shp = x.shape
    xf = x.astype(F32).reshape(shp[:-1] + (2, 2, ROPE_FREQS))
    mid = (1,) * (x.ndim - 3)
    cs = cos.reshape((cos.shape[0],) + mid + (2, ROPE_FREQS))
    sn = sin.reshape((sin.shape[0],) + mid + (2, ROPE_FREQS))
    x1, x2 = xf[..., 0, :], xf[..., 1, :]
    out = jnp.stack([x1 * cs - x2 * sn, x2 * cs + x1 * sn], axis=-2)
    return out.reshape(shp).astype(x.dtype)


def split_columns(w):
    idx = np.cumsum(SPLIT_SIZES)[:-1].tolist()
    return jnp.split(w, idx, axis=-1)


def heads(a, *hd):
    return a.reshape(a.shape[:2] + hd)


def diff_weights(q, k, lam):
    s = jnp.einsum('bqhcd,bkhcd->bhcqk', q, k).astype(F32) * (DIFF_DIM ** -0.5)
    p = jax.nn.softmax(s, axis=-1)
    return p[:, :, 0] - lam * p[:, :, 1]


def diff_attention(q_l, k_l, v_l, q_c, k_c, v_c, lam_vecs, subln, lam_init, need_ctx):
    lv = lam_vecs.astype(F32)
    lam = jnp.exp(jnp.sum(lv[0] * lv[1])) - jnp.exp(jnp.sum(lv[2] * lv[3])) + lam_init
    B, S = q_l.shape[:2]
    nb = S // DIFF_QBLOCK
    k_all = jnp.concatenate([k_c, k_l], axis=1)
    v_all = jnp.concatenate([v_c, v_l], axis=1)
    qb = jnp.moveaxis(q_l.reshape(B, nb, DIFF_QBLOCK, DIFF_HEADS, 2, DIFF_DIM), 1, 0)

    def block(qi):
        w = diff_weights(qi, k_all, lam)
        return jnp.einsum('bhqk,bkhe->bqhe', w.astype(v_all.dtype), v_all)

    o_l = jnp.moveaxis(lax.map(block, qb), 0, 1).reshape(B, S, DIFF_HEADS, DIFF_VDIM)
    out_scale = 1.0 - lam_init
    y_l = (rms_norm(o_l, subln) * out_scale).reshape(B, S, -1)
    y_c = None
    if need_ctx:
        w_c = diff_weights(q_c, k_c, lam)
        o_c = jnp.einsum('bhqk,bkhe->bqhe', w_c.astype(v_c.dtype), v_c)
        y_c = (rms_norm(o_c, subln) * out_scale).reshape(o_c.shape[0], o_c.shape[1], -1)
    return y_l, y_c


def hgrn_gates(z, lb):
    z = z.astype(F32)
    k = (1.0 - lb) * jax.nn.sigmoid(-z)
    logf = jnp.log1p(-k)
    return logf, k


def gla_chunk_scan(q, k, v, logf, s0):
    B, L, H, _ = q.shape
    dv = v.shape[-1]
    n = L // HGRN_CHUNK

    def chunks(a):
        return jnp.moveaxis(a.reshape(B, n, HGRN_CHUNK, H, a.shape[-1]), 1, 0)

    causal = jnp.tril(jnp.ones((HGRN_CHUNK, HGRN_CHUNK), dtype=bool))[:, :, None, None]

    def step(S, inp):
        qc, kc, vc, lc = inp
        b = jnp.cumsum(lc, axis=1)
        o_inter = jnp.einsum('bthk,bhkv->bthv', qc * jnp.exp(b), S)
        rel = jnp.where(causal, b[:, :, None] - b[:, None, :], 0.0)
        decay = jnp.where(causal, jnp.exp(rel), 0.0)
        A = jnp.einsum('bthk,bshk,btshk->bhts', qc, kc, decay)
        o_intra = jnp.einsum('bhts,bshv->bthv', A, vc)
        b_last = b[:, -1]
        S_new = S * jnp.exp(b_last)[..., None] + jnp.einsum(
            'bshk,bshv->bhkv', kc * jnp.exp(b_last[:, None] - b), vc)
        return S_new, o_inter + o_intra

    S_fin, o = lax.scan(step, s0, (chunks(q), chunks(k), chunks(v), chunks(logf)))
    return jnp.moveaxis(o, 0, 1).reshape(B, L, H, dv), S_fin


def hgrn_direction(q_c, z_c, v_c, q_l, z_l, v_l, lb):
    logf_c, k_c = hgrn_gates(z_c, lb)
    logf_l, k_l = hgrn_gates(z_l, lb)
    B, _, H, dk = q_c.shape
    s0 = jnp.zeros((B, H, dk, v_c.shape[-1]), F32)
    o_c, s_c = gla_chunk_scan(q_c, k_c, v_c, logf_c, s0)
    o_l, _ = gla_chunk_scan(q_l, k_l, v_l, logf_l, s_c)
    return o_c, o_l


def hgrn2(q_l, zf_l, zb_l, v_l, g_l, q_c, zf_c, zb_c, v_c, g_c, lb, norm_w, need_ctx):
    q_l, q_c = jax.nn.silu(q_l.astype(F32)), jax.nn.silu(q_c.astype(F32))
    v_l, v_c = v_l.astype(F32), v_c.astype(F32)
    rev = lambda a: a[:, ::-1]
    oc_f, ol_f = hgrn_direction(q_c, zf_c, v_c, q_l, zf_l, v_l, lb[0])
    oc_b, ol_b = hgrn_direction(rev(q_c), rev(zb_c), rev(v_c), rev(q_l), rev(zb_l), rev(v_l), lb[1])

    def readout(o, g):
        y = rms_norm(o, norm_w) * jax.nn.silu(g.astype(F32))
        return y.reshape(y.shape[:2] + (-1,)).astype(g.dtype)

    y_l = readout(ol_f + rev(ol_b), g_l)
    y_c = readout(oc_f + rev(oc_b), g_c) if need_ctx else None
    return y_l, y_c


def swa_latent(q, k, v, k_c, v_c, sink):
    B, S = q.shape[:2]
    C = k_c.shape[1]
    nb = S // SWA_BLOCK
    scale = SWA_DIM ** -0.5
    qb = jnp.moveaxis(q.reshape(B, nb, SWA_BLOCK, SWA_KV_HEADS, SWA_GROUP, SWA_DIM), 1, 0)
    pad = ((0, 0), (SWA_BLOCK, SWA_BLOCK), (0, 0), (0, 0))
    kp, vp = jnp.pad(k, pad), jnp.pad(v, pad)
    qi = jnp.arange(SWA_BLOCK)[:, None]
    kj = jnp.arange(3 * SWA_BLOCK)[None, :]
    band = jnp.abs(kj - SWA_BLOCK - qi) <= WINDOW
    sink_l = sink.astype(F32).reshape(SWA_KV_HEADS, SWA_GROUP, 1, 1)

    def block(args):
        n, qn = args
        start = n * SWA_BLOCK
        kw = lax.dynamic_slice_in_dim(kp, start, 3 * SWA_BLOCK, axis=1)
        vw = lax.dynamic_slice_in_dim(vp, start, 3 * SWA_BLOCK, axis=1)
        kpos = start - SWA_BLOCK + kj
        valid = band & (kpos >= 0) & (kpos < S)
        s_win = jnp.einsum('bqhgd,bkhd->bhgqk', qn, kw).astype(F32) * scale
        s_win = jnp.where(valid, s_win, MASK_VALUE)
        s_ctx = jnp.einsum('bqhgd,bkhd->bhgqk', qn, k_c).astype(F32) * scale
        sk = jnp.broadcast_to(sink_l, s_ctx.shape[:-1] + (1,))
        p = jax.nn.softmax(jnp.concatenate([s_ctx, s_win, sk], axis=-1), axis=-1)
        p_ctx = p[..., :C].astype(v.dtype)
        p_win = p[..., C:C + 3 * SWA_BLOCK].astype(v.dtype)
        return (jnp.einsum('bhgqk,bkhd->bqhgd', p_ctx, v_c)
                + jnp.einsum('bhgqk,bkhd->bqhgd', p_win, vw))

    o = lax.map(block, (jnp.arange(nb), qb))
    return jnp.moveaxis(o, 0, 1).reshape(B, S, SWA_Q_HEADS * SWA_DIM)


def swa_context(q, k, v, sink):
    B, C = q.shape[:2]
    qh = q.reshape(B, C, SWA_KV_HEADS, SWA_GROUP, SWA_DIM)
    s = jnp.einsum('bqhgd,bkhd->bhgqk', qh, k).astype(F32) * (SWA_DIM ** -0.5)
    sk = jnp.broadcast_to(sink.astype(F32).reshape(SWA_KV_HEADS, SWA_GROUP, 1, 1), s.shape[:-1] + (1,))
    p = jax.nn.softmax(jnp.concatenate([s, sk], axis=-1), axis=-1)[..., :C]
    o = jnp.einsum('bhgqk,bkhd->bqhgd', p.astype(v.dtype), v)
    return o.reshape(B, C, SWA_Q_HEADS * SWA_DIM)


def merge_branches(ys, gates, w_branch, w_out):
    g = jax.nn.sigmoid(gates.reshape(gates.shape[:2] + (N_BRANCHES, D_MODEL)))
    merged = g[..., 0, :] * (ys[0] @ w_branch[0])
    for j in range(1, N_BRANCHES):
        merged = merged + g[..., j, :] * (ys[j] @ w_branch[j])
    return merged @ w_out


def token_mixer(h_l, h_c, w_in, lam_vecs, subln, lam_init, lb, hgrn_w, sink,
                w_branch, w_out, cos, sin, need_ctx):
    w_parts = split_columns(w_in)
    (dq_l, dk_l, dv_l, hq_l, hff_l, hfb_l, hi_l, hg_l, sq_l, sk_l, sv_l, gt_l) = [h_l @ w for w in w_parts]
    (dq_c, dk_c, dv_c, hq_c, hff_c, hfb_c, hi_c, hg_c, sq_c, sk_c, sv_c, gt_c) = [h_c @ w for w in w_parts]

    y_a_l, y_a_c = diff_attention(
        apply_axial_rope(heads(dq_l, DIFF_HEADS, 2, DIFF_DIM), cos, sin),
        apply_axial_rope(heads(dk_l, DIFF_HEADS, 2, DIFF_DIM), cos, sin),
        heads(dv_l, DIFF_HEADS, DIFF_VDIM),
        heads(dq_c, DIFF_HEADS, 2, DIFF_DIM), heads(dk_c, DIFF_HEADS, 2, DIFF_DIM),
        heads(dv_c, DIFF_HEADS, DIFF_VDIM), lam_vecs, subln, lam_init, need_ctx)

    hk = lambda a: heads(a, HGRN_HEADS, HGRN_DK)
    hv = lambda a: heads(a, HGRN_HEADS, HGRN_DV)
    y_b_l, y_b_c = hgrn2(hk(hq_l), hk(hff_l), hk(hfb_l), hv(hi_l), hv(hg_l),
                         hk(hq_c), hk(hff_c), hk(hfb_c), hv(hi_c), hv(hg_c), lb, hgrn_w, need_ctx)

    k_c = heads(sk_c, SWA_KV_HEADS, SWA_DIM)
    v_c = heads(sv_c, SWA_KV_HEADS, SWA_DIM)
    y_c_l = swa_latent(apply_axial_rope(heads(sq_l, SWA_Q_HEADS, SWA_DIM), cos, sin),
                       apply_axial_rope(heads(sk_l, SWA_KV_HEADS, SWA_DIM), cos, sin),
                       heads(sv_l, SWA_KV_HEADS, SWA_DIM), k_c, v_c, sink)

    out_l = merge_branches((y_a_l, y_b_l, y_c_l), gt_l, w_branch, w_out)
    out_c = None
    if need_ctx:
        y_c_c = swa_context(heads(sq_c, SWA_Q_HEADS, SWA_DIM), k_c, v_c, sink)
        out_c = merge_branches((y_a_c, y_b_c, y_c_c), gt_c, w_branch, w_out)
    return out_l, out_c


def sq_relu_mlp(h, w_up, w_down):
    return jnp.square(jax.nn.relu(h @ w_up)) @ w_down


def setup_inputs(seed: int = 0) -> dict:
    key = jax.random.key(seed)
    ks = jax.random.split(key, 17)

    def nrm(k, shape, scale):
        return jax.random.normal(k, shape, F32) * scale

    return {
        "x": nrm(ks[0], (BATCH, SEQ, D_MODEL), 1.0),
        "c": nrm(ks[1], (BATCH, D_MODEL), 1.0),
        "ctx": nrm(ks[2], (BATCH, CTX_LEN, D_MODEL), 1.0),
        "c_ctx": nrm(ks[3], (D_MODEL,), 1.0),
        "w_ada": nrm(ks[4], (DEPTH, D_MODEL, 6 * D_MODEL), 0.5 * D_MODEL ** -0.5),
        "b_ada": nrm(ks[5], (DEPTH, 6 * D_MODEL), 0.01),
        "norm_g": 1.0 + nrm(ks[6], (DEPTH, 4, D_MODEL), 0.02),
        "w_in": nrm(ks[7], (DEPTH, D_MODEL, IN_WIDTH), D_MODEL ** -0.5),
        "diff_lambda": nrm(ks[8], (DEPTH, 4, DIFF_DIM), 0.1),
        "diff_subln": 1.0 + nrm(ks[9], (DEPTH, DIFF_VDIM), 0.02),
        "hgrn_lb": nrm(ks[10], (DEPTH, 2, HGRN_HEADS * HGRN_DK), 0.1),
        "hgrn_norm": 1.0 + nrm(ks[11], (DEPTH, HGRN_DV), 0.02),
        "swa_sink": nrm(ks[12], (DEPTH, SWA_Q_HEADS), 0.5),
        "w_branch": nrm(ks[13], (DEPTH, N_BRANCHES, BRANCH_WIDTH, D_MODEL), BRANCH_WIDTH ** -0.5),
        "w_out": nrm(ks[14], (DEPTH, D_MODEL, D_MODEL), D_MODEL ** -0.5),
        "w_mlp_up": nrm(ks[15], (DEPTH, D_MODEL, D_FF), D_MODEL ** -0.5),
        "w_mlp_down": nrm(ks[16], (DEPTH, D_FF, D_MODEL), D_FF ** -0.5),
    }


def reference(x, c, ctx, c_ctx, w_ada, b_ada, norm_g, w_in, diff_lambda, diff_subln,
              hgrn_lb, hgrn_norm, swa_sink, w_branch, w_out, w_mlp_up, w_mlp_down):
    cos, sin = axial_rope_tables(x.shape[1])
    lb_soft = jax.nn.softmax(hgrn_lb.astype(F32), axis=0)
    lower_bounds = (jnp.cumsum(lb_soft, axis=0) - lb_soft[0:1]).reshape(
        lb_soft.shape[:2] + (HGRN_HEADS, HGRN_DK))
    c_act = jax.nn.silu(c)
    cc_act = jax.nn.silu(c_ctx)
    for l in range(DEPTH):
        need_ctx = l < DEPTH - 1
        lam_init = 0.8 - 0.6 * math.exp(-0.3 * l)
        m_l = jnp.split((c_act @ w_ada[l] + b_ada[l])[:, None, :], 6, axis=-1)
        m_c = jnp.split((cc_act @ w_ada[l] + b_ada[l])[None, None, :], 6, axis=-1)

        h_l = modulate(rms_norm(x, norm_g[l, 0]), m_l[0], m_l[1])
        h_c = modulate(rms_norm(ctx, norm_g[l, 0]), m_c[0], m_c[1])
        y_l, y_c = token_mixer(h_l, h_c, w_in[l], diff_lambda[l], diff_subln[l], lam_init,
                               lower_bounds[l], hgrn_norm[l], swa_sink[l], w_branch[l], w_out[l],
                               cos, sin, need_ctx)
        x = x + m_l[2] * rms_norm(y_l, norm_g[l, 1])
        h_l = modulate(rms_norm(x, norm_g[l, 2]), m_l[3], m_l[4])
        x = x + m_l[5] * rms_norm(sq_relu_mlp(h_l, w_mlp_up[l], w_mlp_down[l]), norm_g[l, 3])

        if need_ctx:
            ctx = ctx + m_c[2] * rms_norm(y_c, norm_g[l, 1])
            h_c = modulate(rms_norm(ctx, norm_g[l, 2]), m_c[3], m_c[4])
            ctx = ctx + m_c[5] * rms_norm(sq_relu_mlp(h_c, w_mlp_up[l], w_mlp_down[l]), norm_g[l, 3])
    return x
```

```cpp
#include <hip/hip_runtime.h>
#include <hip/hip_cooperative_groups.h>
#include <cstdio>
#include <cstdint>
namespace cg = cooperative_groups;

#ifndef MK_ONE_LAUNCH
#define MK_ONE_LAUNCH 1
#endif

#ifndef DUP_MASK
#define DUP_MASK 0
#endif
#define DI __device__ __forceinline__
#define LAS __attribute__((address_space(3)))
typedef unsigned short bf16_t;
typedef short bf16x8 __attribute__((ext_vector_type(8)));
typedef float f32x4 __attribute__((ext_vector_type(4)));
typedef float f32x2 __attribute__((ext_vector_type(2)));
typedef float f32x16 __attribute__((ext_vector_type(16)));
typedef unsigned u32x4 __attribute__((ext_vector_type(4)));
typedef unsigned u32x2 __attribute__((ext_vector_type(2)));
typedef __bf16 bf16x2_t __attribute__((ext_vector_type(2)));

constexpr int DM = 1024, NB = 4, SEQ = 8192, CTX = 256, RB = SEQ + CTX, MT = NB * RB, INW = 7936, FF = 4096, DEPTH = 2;
constexpr int NCH = RB / 64;
constexpr float EPS = 1e-6f;
constexpr float LOG2E = 1.4426950408889634f;
constexpr float QSC = 0.125f * LOG2E;
constexpr int YMW = 1536;
constexpr int C_DQ = 0, C_DK = 512, C_DV = 1024, C_HQ = 1536, C_FF = 2048, C_FB = 2560, C_HI = 3072, C_HG = 3584, C_SQ = 4096, C_SK = 4608, C_SV = 4736, C_GT = 4864;

constexpr size_t MiB = 1u << 20;
constexpr size_t WS_MODS = 0;
constexpr size_t WS_ROPE = 256 * 1024;
constexpr size_t WS_BAR = 512 * 1024;
constexpr size_t WS_CTXR = 4 * MiB;
constexpr size_t WS_W = 8 * MiB;
constexpr size_t WO_IN = 0, WO_BR = 16 * MiB, WO_OUT = 19 * MiB, WO_UP = 21 * MiB, WO_DN = 29 * MiB;
constexpr size_t WS_H = 46 * MiB;
constexpr size_t WS_MG = 112 * MiB;
constexpr size_t WS_BIG = 178 * MiB;
constexpr size_t WB_Y = 0, WB_LOGF = 128 * MiB, WB_VT = 161 * MiB, WB_G = 178 * MiB, WB_ST = 244 * MiB, WB_DEC = 277 * MiB, WB_YM = 278 * MiB;
constexpr size_t WS_END = WS_BIG + 303 * MiB;

constexpr int LDS_BYTES = 147456;
constexpr int NTHR = 512;

DI unsigned pk2(float lo, float hi) { f32x2 v = {lo, hi}; bf16x2_t b = __builtin_convertvector(v, bf16x2_t); return __builtin_bit_cast(unsigned, b); }
DI float bflo(unsigned w) { return __uint_as_float(w << 16); }
DI float bfhi(unsigned w) { return __uint_as_float(w & 0xffff0000u); }
DI float ex2(float x) { return __builtin_amdgcn_exp2f(x); }
DI float fexp(float x) { return ex2(x * LOG2E); }
DI float sigm(float x) { return __builtin_amdgcn_rcpf(1.f + fexp(-x)); }
DI float wave_sum(float v) {
#pragma unroll
    for (int o = 1; o < 64; o <<= 1) v += __shfl_xor(v, o);
    return v;
}
DI int otid() { int t = threadIdx.x; asm volatile("" : "+v"(t)); return t; }
DI int swap23(int i) { return (i & 0x13) | ((i & 4) << 1) | ((i & 8) >> 1); }
#define MFMA32(a, b, c) __builtin_amdgcn_mfma_f32_32x32x16_bf16((a), (b), (c), 0, 0, 0)
DI bf16x8 pack8(const f32x16& x, int s) {
    u32x4 p; p.x = pk2(x[8 * s], x[8 * s + 1]); p.y = pk2(x[8 * s + 2], x[8 * s + 3]); p.z = pk2(x[8 * s + 4], x[8 * s + 5]); p.w = pk2(x[8 * s + 6], x[8 * s + 7]);
    return __builtin_bit_cast(bf16x8, p);
}

namespace pg8 {
constexpr int BM = 256, BK = 64, HALF = 128, HTB = HALF * BK * 2, STAGE_BYTES = 8 * HTB, NXCD = 8, WGM = 8;
DI int lds_byte(int r, int c) { const int st = (r >> 4) * 2 + (c >> 5), rr = r & 15, cc = c & 31, ob = rr * 64 + cc * 2; return st * 1024 + (ob ^ (((ob >> 9) & 1) << 5)); }
DI void stage_rc(int b, int& R, int& C) { const int st = b / 1024, sb = b % 1024, swz = sb ^ (((sb >> 9) & 1) << 5); R = (st >> 1) * 16 + swz / 64; C = (st & 1) * 32 + (swz % 64) / 2; }
DI int perm32(int rho) { const int n = rho >> 4, i = rho & 15; return 8 * (i >> 2) + 4 * n + (i & 3); }
struct Unit { int pm, pn, kind; };
struct GemmDesc { int lda, ldb, K; };
DI void tile_map(int L, int nM, int nN, int& pm, int& pn) {
    const int nwg = nM * nN; int wgid = L;
    { const int q = nwg / NXCD, r = nwg % NXCD, xcd = wgid % NXCD, off = wgid / NXCD; wgid = (xcd < r ? xcd * (q + 1) : r * (q + 1) + (xcd - r) * q) + off; }
    const int nig = WGM * nN, gid = wgid / nig, fm = gid * WGM, gsz = (nM - fm) < WGM ? (nM - fm) : WGM;
    pm = fm + ((wgid % nig) % gsz); pn = (wgid % nig) / gsz;
}

template <class Epi, class Sched>
DI void gemm_phase(LAS unsigned char* lds, const GemmDesc g, const Sched& S, const Epi& E) {
    const int tid = otid(), wid = __builtin_amdgcn_readfirstlane(tid >> 6), lane = tid & 63, wr = wid >> 2, wc = wid & 3, fr = lane & 15, fq = lane >> 4;
    const int K = g.K, nt = K / BK;
    unsigned voffA[2], voffB[2];
#pragma unroll
    for (int i = 0; i < 2; ++i) { int R, C; stage_rc(tid * 16 + i * 8192, R, C); const int Rb = (R & ~31) + perm32(R & 31);
        voffA[i] = (unsigned)(R * g.lda + C) * 2u; voffB[i] = (unsigned)(Rb * g.ldb + C) * 2u; }
    const size_t kstep = (size_t)(BK * 2);
    const size_t hstepA = (size_t)HALF * g.lda * 2, hstepB = (size_t)HALF * g.ldb * 2;
    const unsigned ldsw = (unsigned)wid * 1024u;
    const int aoff = lds_byte(wr * 64 + fr, fq * 8), boff = lds_byte(wc * 32 + fr, fq * 8);
#define PG8_SA(b, h) (((b) * 2 + (h)) * HTB)
#define PG8_SB(b, h) ((4 + (b) * 2 + (h)) * HTB)
#define PG8_STAGE(bufoff, gbase, voff) do { _Pragma("unroll") for (int _i = 0; _i < 2; ++_i) \
        __builtin_amdgcn_global_load_lds((const unsigned*)((const char*)(gbase) + (voff)[_i]), (LAS unsigned*)(lds + (bufoff) + ldsw + _i * 8192), 16, 0, 0); } while (0)
#define PG8_LDA(dst, b, h) do { _Pragma("unroll") for (int m = 0; m < 4; ++m) _Pragma("unroll") for (int k = 0; k < 2; ++k) dst[m][k] = *(const LAS bf16x8*)(lds + PG8_SA(b, h) + aoff + m * 2048 + k * 1024); } while (0)
#define PG8_LDB(dst, b, h) do { _Pragma("unroll") for (int n = 0; n < 2; ++n) _Pragma("unroll") for (int k = 0; k < 2; ++k) dst[n][k] = *(const LAS bf16x8*)(lds + PG8_SB(b, h) + boff + n * 2048 + k * 1024); } while (0)
#define PG8_MMA(ai, bj, At, Bt) do { __builtin_amdgcn_s_setprio(1); _Pragma("unroll") for (int m = 0; m < 4; ++m) _Pragma("unroll") for (int n = 0; n < 2; ++n) _Pragma("unroll") for (int k = 0; k < 2; ++k) \
        acc[ai][bj][m][n] = __builtin_amdgcn_mfma_f32_16x16x32_bf16(Bt[n][k], At[m][k], acc[ai][bj][m][n], 0, 0, 0); __builtin_amdgcn_s_setprio(0); } while (0)
#define PG8_WAIT_V(n) asm volatile("s_waitcnt vmcnt(" #n ")" ::: "memory")
#define PG8_WAIT_L(n) asm volatile("s_waitcnt lgkmcnt(" #n ")" ::: "memory")
#define PG8_BAR __builtin_amdgcn_s_barrier()
#define PG8_SCHED __builtin_amdgcn_sched_barrier(0)
    Unit cur, nxt; int ui = 0;
    if (!S.next(0, cur)) return;
    f32x4 acc[2][2][4][2];
#pragma unroll
    for (int a = 0; a < 2; ++a)
#pragma unroll
        for (int b = 0; b < 2; ++b)
#pragma unroll
            for (int m = 0; m < 4; ++m)
#pragma unroll
                for (int n = 0; n < 2; ++n) acc[a][b][m][n] = (f32x4){0.f, 0.f, 0.f, 0.f};
    bf16x8 At[4][2], B0[2][2], B1[2][2];
    const char* cA = S.a_ptr(cur); const char* cB = S.b_ptr(cur);
    PG8_STAGE(PG8_SB(0, 0), cB, voffB); PG8_STAGE(PG8_SB(0, 1), cB + hstepB, voffB); PG8_STAGE(PG8_SA(0, 0), cA, voffA); PG8_STAGE(PG8_SA(0, 1), cA + hstepA, voffA);
    if (wr == 1) PG8_BAR;
    PG8_WAIT_V(2); PG8_BAR;
    PG8_STAGE(PG8_SB(1, 0), cB + kstep, voffB); PG8_STAGE(PG8_SA(1, 0), cA + kstep, voffA); PG8_STAGE(PG8_SB(1, 1), cB + hstepB + kstep, voffB);
    PG8_WAIT_V(6); PG8_BAR;
    for (;;) {
        const bool has_next = S.next(ui + 1, nxt);
        const char* nA = has_next ? S.a_ptr(nxt) : cA; const char* nB = has_next ? S.b_ptr(nxt) : cB;
        for (int t = 0; t < nt; t += 2) {
            const bool last = (t == nt - 2);
            const char* a1 = cA + (size_t)(t + 1) * kstep;
            const char* a2 = last ? nA : cA + (size_t)(t + 2) * kstep; const char* b2 = last ? nB : cB + (size_t)(t + 2) * kstep;
            const char* a3 = a2 + kstep; const char* b3 = b2 + kstep;
            PG8_LDB(B0, 0, 0); PG8_LDB(B1, 0, 1); PG8_SCHED; PG8_LDA(At, 0, 0); PG8_STAGE(PG8_SA(1, 1), a1 + hstepA, voffA);
            PG8_WAIT_V(8); PG8_WAIT_L(0); PG8_BAR; PG8_MMA(0, 0, At, B0); PG8_MMA(0, 1, At, B1); PG8_BAR; PG8_SCHED;
            PG8_LDA(At, 0, 1); PG8_STAGE(PG8_SB(0, 0), b2, voffB); PG8_STAGE(PG8_SB(0, 1), b2 + hstepB, voffB); PG8_STAGE(PG8_SA(0, 0), a2, voffA);
            PG8_WAIT_V(8); PG8_WAIT_L(0); PG8_BAR; PG8_MMA(1, 0, At, B0); PG8_MMA(1, 1, At, B1); PG8_BAR; PG8_SCHED;
            PG8_LDB(B0, 1, 0); PG8_LDB(B1, 1, 1); PG8_SCHED; PG8_LDA(At, 1, 0); PG8_STAGE(PG8_SA(0, 1), a2 + hstepA, voffA);
            PG8_WAIT_V(8); PG8_WAIT_L(0); PG8_BAR; PG8_MMA(0, 0, At, B0); PG8_MMA(0, 1, At, B1); PG8_BAR; PG8_SCHED;
            PG8_LDA(At, 1, 1); PG8_STAGE(PG8_SB(1, 0), b3, voffB); PG8_STAGE(PG8_SB(1, 1), b3 + hstepB, voffB); PG8_STAGE(PG8_SA(1, 0), a3, voffA);
            PG8_WAIT_V(8); PG8_WAIT_L(0); PG8_BAR; PG8_MMA(1, 0, At, B0); PG8_MMA(1, 1, At, B1); PG8_BAR; PG8_SCHED;
        }
        if (wr == 0) PG8_BAR;
        E(acc, cur, wr, wc, fr, fq);
        if (!has_next) break;
#pragma unroll
        for (int a = 0; a < 2; ++a)
#pragma unroll
            for (int b = 0; b < 2; ++b)
#pragma unroll
                for (int m = 0; m < 4; ++m)
#pragma unroll
                    for (int n = 0; n < 2; ++n) acc[a][b][m][n] = (f32x4){0.f, 0.f, 0.f, 0.f};
        cur = nxt; cA = nA; cB = nB; ++ui;
        if (wr == 1) PG8_BAR;
    }
    PG8_WAIT_V(0);
    PG8_BAR;
#undef PG8_SA
#undef PG8_SB
#undef PG8_STAGE
#undef PG8_LDA
#undef PG8_LDB
#undef PG8_MMA
#undef PG8_WAIT_V
#undef PG8_WAIT_L
#undef PG8_BAR
#undef PG8_SCHED
}
}
using pg8::Unit;

struct SchedWin {
    const char* H; const char* W; int G, c;
    DI bool next(int i, Unit& u) const {
        const int L = i * G + c; if (L >= 1023) return false;
        if (L < 891) { int pm, lp; pg8::tile_map(L, 33, 27, pm, lp); u.pm = pm; u.pn = lp + (lp >= 4 ? 2 : 0) + (lp >= 10 ? 2 : 0); u.kind = 0; }
        else { const int Ls = L - 891; u.pm = Ls / 33; u.pn = Ls % 33; u.kind = 1; }
        return true;
    }
    DI const char* a_ptr(const Unit& u) const { return u.kind == 0 ? H + (size_t)u.pm * 256 * DM * 2 : W + (size_t)((u.pm < 2 ? C_DV : C_HI - 512) + u.pm * 256) * DM * 2; }
    DI const char* b_ptr(const Unit& u) const { return u.kind == 0 ? W + (size_t)u.pn * 256 * DM * 2 : H + (size_t)u.pn * 256 * DM * 2; }
};
struct SchedMerge {
    const char* YM; const char* WB; int c;
    DI bool next(int i, Unit& u) const { if (i >= 3 || c >= 132) return false; u.pm = c >> 2; u.pn = c & 3; u.kind = i; return true; }
    DI const char* a_ptr(const Unit& u) const { return YM + ((size_t)u.pm * 256 * YMW + u.kind * 512) * 2; }
    DI const char* b_ptr(const Unit& u) const { return WB + ((size_t)u.kind * DM * 512 + (size_t)u.pn * 256 * 512) * 2; }
};
struct SchedPlain {
    const char* A; const char* Bt; int nM, nN, K, G, c; bool skip;
    DI bool next(int i, Unit& u) const { const int L = i * G + c; if (L >= nM * nN) return false; pg8::tile_map(L, nM, nN, u.pm, u.pn); if (skip) u.pm += u.pm / 32 + 1; u.kind = 0; return true; }
    DI const char* a_ptr(const Unit& u) const { return A + (size_t)u.pm * 256 * K * 2; }
    DI const char* b_ptr(const Unit& u) const { return Bt + (size_t)u.pn * 256 * K * 2; }
};

struct EpiWin {
    bf16_t* Yb; float* LOGF; bf16_t* VT; const float* cosT; const float* sinT; const float* hlb; int layer;
    DI void operator()(const f32x4 (&acc)[2][2][4][2], const Unit& u, int wr, int wc, int fr, int fq) const {
        if (u.kind == 1) {
            const int row0 = u.pm * 256 + wr * 64 + fr, col0 = u.pn * 256 + wc * 32 + 8 * fq;
#pragma unroll
            for (int ai = 0; ai < 2; ++ai)
#pragma unroll
                for (int m = 0; m < 4; ++m) { bf16_t* rowp = VT + (size_t)(row0 + ai * 128 + m * 16) * RB + col0;
#pragma unroll
                    for (int bj = 0; bj < 2; ++bj) { const f32x4 v0 = acc[ai][bj][m][0], v1 = acc[ai][bj][m][1];
                        u32x4 w; w.x = pk2(v0[0], v0[1]); w.y = pk2(v0[2], v0[3]); w.z = pk2(v1[0], v1[1]); w.w = pk2(v1[2], v1[3]);
                        *(u32x4*)(rowp + bj * 128) = w; } }
            return;
        }
        const int pn = u.pn;
        int type; float sc = 1.f;
        if (pn < 2) { type = 0; sc = QSC; } else if (pn < 4) type = 1; else if (pn < 8) type = 2; else if (pn < 12) type = 3; else if (pn < 16) type = 2;
        else if (pn < 18) { type = 0; sc = QSC; } else if (pn == 18) type = 4; else type = 5;
        const bool latent = (u.pm != 0);
        const int cbase = pn * 256 + wc * 32 + 8 * fq;
        float lbv[2][8];
        if (type == 3) {
#pragma unroll
            for (int bj = 0; bj < 2; ++bj)
#pragma unroll
                for (int j = 0; j < 8; ++j) { float lb = 0.f; if (layer == 1) { const int ci = cbase + bj * 128 + j - C_FF; const float a0 = hlb[ci], a1 = hlb[1024 + ci]; lb = __builtin_amdgcn_rcpf(1.f + fexp(a0 - a1)); } lbv[bj][j] = lb; }
        }
        const float sgn = (fq >> 1) ? 1.f : -1.f;
#pragma unroll
        for (int ai = 0; ai < 2; ++ai)
#pragma unroll
            for (int m = 0; m < 4; ++m) {
                const int rl = u.pm * 256 + ai * 128 + wr * 64 + m * 16 + fr;
                float cs[8], sn[8];
                const bool dorope = (type == 0 || type == 1 || type == 4) && latent;
                if (dorope) { const int t = rl - CTX; const int pos = (wc & 1) ? (t & 63) : (t >> 6); const int o = pos * 16 + 8 * (fq & 1);
                    const f32x4 c0 = *(const f32x4*)(cosT + o), c1 = *(const f32x4*)(cosT + o + 4), s0 = *(const f32x4*)(sinT + o), s1 = *(const f32x4*)(sinT + o + 4);
#pragma unroll
                    for (int j = 0; j < 4; ++j) { cs[j] = c0[j]; cs[4 + j] = c1[j]; sn[j] = s0[j]; sn[4 + j] = s1[j]; } }
#pragma unroll
                for (int bj = 0; bj < 2; ++bj) {
                    float v[8];
#pragma unroll
                    for (int j = 0; j < 4; ++j) { v[j] = acc[ai][bj][m][0][j]; v[4 + j] = acc[ai][bj][m][1][j]; }
                    const int col = cbase + bj * 128;
                    if (type == 3) {
                        float o8[8];
#pragma unroll
                        for (int j = 0; j < 8; ++j) { const float kg = (1.f - lbv[bj][j]) * sigm(-v[j]); o8[j] = __logf(1.f - kg); }
#pragma unroll
                        for (int j = 0; j < 8; ++j) v[j] = o8[j];
                    }
                    if (type == 3) { } else if (type == 0 || type == 1 || (type == 4 && bj == 0)) {
                        if (dorope) {
#pragma unroll
                            for (int j = 0; j < 8; ++j) { const float pr = __shfl_xor(v[j], 32); v[j] = v[j] * cs[j] + sgn * pr * sn[j]; }
                        }
#pragma unroll
                        for (int j = 0; j < 8; ++j) v[j] *= sc;
                    } else if (type == 2) {
#pragma unroll
                        for (int j = 0; j < 8; ++j) v[j] = v[j] * sigm(v[j]);
                    } else if (type == 5) {
#pragma unroll
                        for (int j = 0; j < 8; ++j) v[j] = sigm(v[j]);
                    }
                    u32x4 w; w.x = pk2(v[0], v[1]); w.y = pk2(v[2], v[3]); w.z = pk2(v[4], v[5]); w.w = pk2(v[6], v[7]);
                    *(u32x4*)(Yb + (size_t)rl * INW + col) = w;
                }
            }
    }
};
struct EpiMerge {
    const bf16_t* Yb; bf16_t* MS_unused; bf16_t* MG;
    template <int J> DI void body(const f32x4 (&acc)[2][2][4][2], const Unit& u, int wr, int wc, int fr, int fq) const {
        const unsigned cbase = u.pn * 256 + wc * 32 + 8 * fq;
        const unsigned row0 = u.pm * 256 + wr * 64 + fr;
#pragma unroll
        for (int ai = 0; ai < 2; ++ai)
#pragma unroll
            for (int m = 0; m < 4; ++m) { unsigned rl = row0 + ai * 128 + m * 16; asm volatile("" : "+v"(rl));
                const unsigned go = rl * INW + C_GT + J * 1024 + cbase, mo = rl * DM + cbase;
#pragma unroll
                for (int bj = 0; bj < 2; ++bj) {
                    const u32x4 gw = *(const u32x4*)(Yb + go + bj * 128);
                    const f32x4 a0 = acc[ai][bj][m][0], a1 = acc[ai][bj][m][1];
                    f32x4 v0 = {a0[0] * bflo(gw.x), a0[1] * bfhi(gw.x), a0[2] * bflo(gw.y), a0[3] * bfhi(gw.y)};
                    f32x4 v1 = {a1[0] * bflo(gw.z), a1[1] * bfhi(gw.z), a1[2] * bflo(gw.w), a1[3] * bfhi(gw.w)};
                    bf16_t* mg = MG + mo + bj * 128;
                    if (J > 0) { const u32x4 pw = *(const u32x4*)mg; v0 += (f32x4){bflo(pw.x), bfhi(pw.x), bflo(pw.y), bfhi(pw.y)}; v1 += (f32x4){bflo(pw.z), bfhi(pw.z), bflo(pw.w), bfhi(pw.w)}; }
                    u32x4 w; w.x = pk2(v0[0], v0[1]); w.y = pk2(v0[2], v0[3]); w.z = pk2(v1[0], v1[1]); w.w = pk2(v1[2], v1[3]); *(u32x4*)mg = w; }
                asm volatile("" ::: "memory"); }
    }
    DI void operator()(const f32x4 (&acc)[2][2][4][2], const Unit& u, int wr, int wc, int fr, int fq) const {
        if (u.kind == 0) body<0>(acc, u, wr, wc, fr, fq); else if (u.kind == 1) body<1>(acc, u, wr, wc, fr, fq); else body<2>(acc, u, wr, wc, fr, fq);
    }
};
template <int MODE  > struct EpiStore {
    void* O; int ldc;
    DI void operator()(const f32x4 (&acc)[2][2][4][2], const Unit& u, int wr, int wc, int fr, int fq) const {
        const int cbase = u.pn * 256 + wc * 32 + 8 * fq;
#pragma unroll
        for (int ai = 0; ai < 2; ++ai)
#pragma unroll
            for (int m = 0; m < 4; ++m) { const size_t r = (size_t)(u.pm * 256 + ai * 128 + wr * 64 + m * 16 + fr);
#pragma unroll
                for (int bj = 0; bj < 2; ++bj) { const int col = cbase + bj * 128; f32x4 v0 = acc[ai][bj][m][0], v1 = acc[ai][bj][m][1];
                    if (MODE == 0) { float* o = (float*)O + r * ldc + col; *(f32x4*)o = v0; *(f32x4*)(o + 4) = v1; }
                    else { if (MODE == 2) {
#pragma unroll
                            for (int q = 0; q < 4; ++q) { const float a = fmaxf(v0[q], 0.f), b = fmaxf(v1[q], 0.f); v0[q] = a * a; v1[q] = b * b; } }
                        u32x4 w; w.x = pk2(v0[0], v0[1]); w.y = pk2(v0[2], v0[3]); w.z = pk2(v1[0], v1[1]); w.w = pk2(v1[2], v1[3]); *(u32x4*)((bf16_t*)O + r * ldc + col) = w; } } }
    }
};

DI void transpose_item(const float* W, int K, int N, bf16_t* WT, LAS float* scr, int item, int lane) {
    const int nblk = N / 32, kb = item / nblk, nb = item % nblk, k0 = 64 * kb, n0 = 32 * nb;
#pragma unroll 8
    for (int i = 0; i < 32; ++i) { const int kk = 2 * i + (lane >> 5); scr[kk * 33 + (lane & 31)] = W[(size_t)(k0 + kk) * N + n0 + (lane & 31)]; }
    asm volatile("s_waitcnt lgkmcnt(0)" ::: "memory");
    const int c = lane & 7;
#pragma unroll
    for (int j = 0; j < 4; ++j) { const int n = (lane >> 3) + 8 * j; const LAS float* s = scr + (8 * c) * 33 + n;
        u32x4 o; o.x = pk2(s[0 * 33], s[1 * 33]); o.y = pk2(s[2 * 33], s[3 * 33]); o.z = pk2(s[4 * 33], s[5 * 33]); o.w = pk2(s[6 * 33], s[7 * 33]);
        *(u32x4*)(WT + (size_t)(n0 + n) * K + k0 + 8 * c) = o; }
    asm volatile("s_waitcnt lgkmcnt(0)" ::: "memory");
}
struct Ptrs {
    const float *x, *c, *ctx, *c_ctx, *w_ada, *b_ada, *norm_g, *w_in, *diff_lambda, *diff_subln, *hgrn_lb, *hgrn_norm, *swa_sink, *w_branch, *w_out, *w_up, *w_dn;
    float* out; unsigned char* ws;
};
DI void convert_weights(const Ptrs& P, int l, LAS unsigned char* lds, int gw, int ngw, int wave, int lane) {
    LAS float* scr = (LAS float*)(lds + wave * 16384);
    bf16_t* Wb = (bf16_t*)(P.ws + WS_W);
    constexpr int I_IN = 16 * (INW / 32), I_BR = 8 * 32, I_OUT = 16 * 32, I_UP = 16 * 128, I_DN = 64 * 32;
    constexpr int NIT = I_IN + 3 * I_BR + I_OUT + I_UP + I_DN;
    for (int it = gw; it < NIT; it += ngw) {
        int r = it;
        if (r < I_IN) { transpose_item(P.w_in + (size_t)l * DM * INW, DM, INW, Wb + WO_IN / 2, scr, r, lane); continue; } r -= I_IN;
        if (r < 3 * I_BR) { const int j = r / I_BR; transpose_item(P.w_branch + ((size_t)l * 3 + j) * 512 * DM, 512, DM, Wb + WO_BR / 2 + (size_t)j * DM * 512, scr, r % I_BR, lane); continue; } r -= 3 * I_BR;
        if (r < I_OUT) { transpose_item(P.w_out + (size_t)l * DM * DM, DM, DM, Wb + WO_OUT / 2, scr, r, lane); continue; } r -= I_OUT;
        if (r < I_UP) { transpose_item(P.w_up + (size_t)l * DM * FF, DM, FF, Wb + WO_UP / 2, scr, r, lane); continue; } r -= I_UP;
        transpose_item(P.w_dn + (size_t)l * FF * DM, FF, DM, Wb + WO_DN / 2, scr, r, lane);
    }
}
DI void mods_item(const Ptrs& P, int item, LAS unsigned char* lds, int tid, int wave, int lane) {
    LAS float* act = (LAS float*)lds;
    LAS float* red = (LAS float*)(lds + 20480);
    const int l = item / 96, cb = item % 96, n = cb * 64 + lane;
    for (int i = tid; i < 5 * 1024; i += NTHR) { const int v = i >> 10, k = i & 1023; const float cv = v < 4 ? P.c[v * 1024 + k] : P.c_ctx[k]; act[i] = cv * sigm(cv); }
    __syncthreads();
    float a0 = 0.f, a1 = 0.f, a2 = 0.f, a3 = 0.f, a4 = 0.f;
    const float* wp = P.w_ada + (size_t)l * DM * 6144 + n;
#pragma unroll 8
    for (int kk = 0; kk < 128; ++kk) { const int k = wave * 128 + kk; const float w = wp[(size_t)k * 6144];
        a0 += act[k] * w; a1 += act[1024 + k] * w; a2 += act[2048 + k] * w; a3 += act[3072 + k] * w; a4 += act[4096 + k] * w; }
    red[(wave * 5 + 0) * 64 + lane] = a0; red[(wave * 5 + 1) * 64 + lane] = a1; red[(wave * 5 + 2) * 64 + lane] = a2; red[(wave * 5 + 3) * 64 + lane] = a3; red[(wave * 5 + 4) * 64 + lane] = a4;
    __syncthreads();
    if (tid < 320) { const int v = tid >> 6, ln = tid & 63; float s = P.b_ada[l * 6144 + cb * 64 + ln];
#pragma unroll
        for (int w = 0; w < 8; ++w) s += red[(w * 5 + v) * 64 + ln];
        ((float*)(P.ws + WS_MODS))[(l * 5 + v) * 6144 + cb * 64 + ln] = s; }
    __syncthreads();
}
template <int ADD  >
DI void row_update(const float* res_in, float* res_out, const void* add_row, const float* gate, const float* gain_add,
                   const float* gain_h, const float* shift, const float* scale, bf16_t* hrow, int lane) {
    f32x4 v[4];
#pragma unroll
    for (int j = 0; j < 4; ++j) v[j] = *(const f32x4*)(res_in + 4 * lane + 256 * j);
    if (ADD != 0) {
        f32x4 y[4]; float ss = 0.f;
#pragma unroll
        for (int j = 0; j < 4; ++j) {
            if (ADD == 1) y[j] = *(const f32x4*)((const float*)add_row + 4 * lane + 256 * j);
            else { const u32x2 w = *(const u32x2*)((const bf16_t*)add_row + 4 * lane + 256 * j); y[j] = (f32x4){bflo(w.x), bfhi(w.x), bflo(w.y), bfhi(w.y)}; }
            ss += (y[j][0] * y[j][0] + y[j][1] * y[j][1]) + (y[j][2] * y[j][2] + y[j][3] * y[j][3]); }
        const float rstd = __builtin_amdgcn_rsqf(wave_sum(ss) * (1.f / DM) + EPS);
#pragma unroll
        for (int j = 0; j < 4; ++j) { const f32x4 gt = *(const f32x4*)(gate + 4 * lane + 256 * j), ga = *(const f32x4*)(gain_add + 4 * lane + 256 * j);
            v[j] += gt * (y[j] * rstd * ga); }
    }
    if (res_out) {
#pragma unroll
        for (int j = 0; j < 4; ++j) *(f32x4*)(res_out + 4 * lane + 256 * j) = v[j];
    }
    if (hrow) {
        float ss = 0.f;
#pragma unroll
        for (int j = 0; j < 4; ++j) ss += (v[j][0] * v[j][0] + v[j][1] * v[j][1]) + (v[j][2] * v[j][2] + v[j][3] * v[j][3]);
        const float rstd = __builtin_amdgcn_rsqf(wave_sum(ss) * (1.f / DM) + EPS);
#pragma unroll
        for (int j = 0; j < 4; ++j) { const f32x4 gh = *(const f32x4*)(gain_h + 4 * lane + 256 * j), sh = *(const f32x4*)(shift + 4 * lane + 256 * j), scl = *(const f32x4*)(scale + 4 * lane + 256 * j);
            const f32x4 h = (v[j] * rstd * gh) * (scl + 1.f) + sh;
            u32x2 w; w.x = pk2(h[0], h[1]); w.y = pk2(h[2], h[3]); *(u32x2*)(hrow + 4 * lane + 256 * j) = w; }
    }
}

DI void diff_attn_unit(LAS unsigned char* lds, const bf16_t* Yb, const bf16_t* VTb, bf16_t* YMb, int h, int q0, int nkeys, float lam, const float* subln, float oscale, const unsigned* kmaxp) {
    const int tid = otid(), lane = tid & 63, wid = __builtin_amdgcn_readfirstlane(tid >> 6), r32 = lane & 31, hi = lane >> 5;
    const int c = wid & 1, sub = wid >> 1;
    constexpr int KROW = 272, KBUF = 64 * KROW, VROW = 144, VBUF = 128 * VROW, VOFF = 2 * KBUF;
    const bf16_t* kg = Yb + C_DK + h * 128;
    const bf16_t* vg = VTb + (size_t)(h * 128) * RB;
    const int kr0 = tid >> 4, kc0 = tid & 15, vr0 = tid >> 3, vc0 = tid & 7;
    bf16x8 qf[4];
    { const bf16_t* qp = Yb + (size_t)(q0 + 32 * sub + r32) * INW + C_DQ + h * 128 + c * 64 + hi * 8;
#pragma unroll
      for (int d0 = 0; d0 < 4; ++d0) qf[d0] = *(const bf16x8*)(qp + 16 * d0); }
    bf16x8 qf4, kone, ones;
    { float ss = 0.f;
#pragma unroll
      for (int d0 = 0; d0 < 4; ++d0)
#pragma unroll
          for (int j = 0; j < 8; ++j) { const float v = __uint_as_float(((unsigned)(unsigned short)qf[d0][j]) << 16); ss += v * v; }
      ss += __shfl_xor(ss, 32);
      const float mub = sqrtf(ss) * __uint_as_float(kmaxp[h * 2 + c]) * 1.01f;
      const short e = hi == 0 ? (short)(pk2(-mub, 0.f) & 0xffffu) : (short)0, o1 = hi == 0 ? (short)0x3F80 : (short)0;
      qf4 = (bf16x8){e, 0, 0, 0, 0, 0, 0, 0}; kone = (bf16x8){o1, 0, 0, 0, 0, 0, 0, 0};
      ones = (bf16x8){(short)0x3F80, (short)0x3F80, (short)0x3F80, (short)0x3F80, (short)0x3F80, (short)0x3F80, (short)0x3F80, (short)0x3F80}; }
    f32x16 O[4], L;
#pragma unroll
    for (int r = 0; r < 16; ++r) { O[0][r] = 0.f; O[1][r] = 0.f; O[2][r] = 0.f; O[3][r] = 0.f; L[r] = 0.f; }
    const int NT = nkeys / 64;
    u32x4 kr[1][2], vr[1][2];
    f32x16 P0, P1;
#define DA_LOADK(S, t) do { kr[S][0] = *(const u32x4*)(kg + (size_t)((t) * 64 + kr0) * INW + kc0 * 8); kr[S][1] = *(const u32x4*)(kg + (size_t)((t) * 64 + kr0 + 32) * INW + kc0 * 8); } while (0)
#define DA_LOADV(S, t) do { vr[S][0] = *(const u32x4*)(vg + (size_t)vr0 * RB + (t) * 64 + vc0 * 8); vr[S][1] = *(const u32x4*)(vg + (size_t)(vr0 + 64) * RB + (t) * 64 + vc0 * 8); } while (0)
#define DA_STOREK(S, b) do { *(LAS u32x4*)(lds + (b) * KBUF + kr0 * KROW + kc0 * 16) = kr[S][0]; *(LAS u32x4*)(lds + (b) * KBUF + (kr0 + 32) * KROW + kc0 * 16) = kr[S][1]; } while (0)
#define DA_STOREV(S, b) do { *(LAS u32x4*)(lds + VOFF + (b) * VBUF + vr0 * VROW + vc0 * 16) = vr[S][0]; *(LAS u32x4*)(lds + VOFF + (b) * VBUF + (vr0 + 64) * VROW + vc0 * 16) = vr[S][1]; } while (0)
    const int kro = swap23(r32) * KROW + (c * 64 + 8 * hi) * 2;
    const int vro = VOFF + r32 * VROW + hi * 16;
    DA_LOADK(0, 0); DA_STOREK(0, 0);
    __syncthreads();
    {
        DA_LOADK(0, 1); DA_LOADV(0, 0);
        asm volatile("" ::: "memory");
        const LAS unsigned char* kb = lds + kro;
#pragma unroll
        for (int r = 0; r < 16; ++r) { P0[r] = 0.f; P1[r] = 0.f; }
        P0 = MFMA32(kone, qf4, P0); P1 = MFMA32(kone, qf4, P1);
#pragma unroll
        for (int d0 = 0; d0 < 4; ++d0) { const bf16x8 a0 = *(const LAS bf16x8*)(kb + d0 * 32), a1 = *(const LAS bf16x8*)(kb + 32 * KROW + d0 * 32);
            P0 = MFMA32(a0, qf[d0], P0); P1 = MFMA32(a1, qf[d0], P1); }
#pragma unroll
        for (int r = 0; r < 16; ++r) { P0[r] = ex2(P0[r]); P1[r] = ex2(P1[r]); }
        DA_STOREK(0, 1); DA_STOREV(0, 0);
        __syncthreads();
    }
#define DA_ITER(t, LS, SS) do { \
        const int b = (t) & 1; \
        if ((t) + 1 < NT) DA_LOADK(0, (t) + 1); \
        DA_LOADV(0, (t)); \
        asm volatile("" ::: "memory"); \
        const LAS unsigned char* kb = lds + b * KBUF + kro; \
        const LAS unsigned char* vb = lds + (b ^ 1) * VBUF + vro; \
        f32x16 s0, s1; \
        _Pragma("unroll") for (int r = 0; r < 16; ++r) { s0[r] = 0.f; s1[r] = 0.f; } \
        s0 = MFMA32(kone, qf4, s0); s1 = MFMA32(kone, qf4, s1); \
        _Pragma("unroll") for (int d0 = 0; d0 < 4; ++d0) { const bf16x8 a0 = *(const LAS bf16x8*)(kb + d0 * 32), a1 = *(const LAS bf16x8*)(kb + 32 * KROW + d0 * 32); \
            s0 = MFMA32(a0, qf[d0], s0); s1 = MFMA32(a1, qf[d0], s1); } \
        bf16x8 pf[4]; pf[0] = pack8(P0, 0); pf[1] = pack8(P0, 1); pf[2] = pack8(P1, 0); pf[3] = pack8(P1, 1); \
        _Pragma("unroll") for (int sp = 0; sp < 4; ++sp) { \
            _Pragma("unroll") for (int dvb = 0; dvb < 4; ++dvb) { const bf16x8 a = *(const LAS bf16x8*)(vb + dvb * 32 * VROW + sp * 32); O[dvb] = MFMA32(a, pf[sp], O[dvb]); } \
            L = MFMA32(ones, pf[sp], L); } \
        _Pragma("unroll") for (int r = 0; r < 16; ++r) { P0[r] = ex2(s0[r]); P1[r] = ex2(s1[r]); } \
        asm volatile("" : "+v"(P0), "+v"(P1)); \
        __builtin_amdgcn_sched_group_barrier(0x100, 4, 0); \
        __builtin_amdgcn_sched_group_barrier(0x008, 2, 0); \
        _Pragma("unroll") for (int i = 0; i < 8; ++i) { __builtin_amdgcn_sched_group_barrier(0x008, 1, 0); __builtin_amdgcn_sched_group_barrier(0x100, 1, 0); __builtin_amdgcn_sched_group_barrier(0x002, 2, 0); } \
        _Pragma("unroll") for (int i = 0; i < 12; ++i) { __builtin_amdgcn_sched_group_barrier(0x008, 1, 0); __builtin_amdgcn_sched_group_barrier(0x100, 1, 0); __builtin_amdgcn_sched_group_barrier(0x002, 2, 0); } \
        _Pragma("unroll") for (int i = 0; i < 8; ++i) { __builtin_amdgcn_sched_group_barrier(0x008, 1, 0); __builtin_amdgcn_sched_group_barrier(0x002, 1, 0); } \
        __builtin_amdgcn_sched_barrier(0); \
        if ((t) + 1 < NT) DA_STOREK(0, b ^ 1); \
        DA_STOREV(0, b); \
        __syncthreads(); \
    } while (0)
    if (wid >= 4) __builtin_amdgcn_s_setprio(1);
#pragma clang loop unroll(disable)
    for (int t = 1; t < NT; ++t) { DA_ITER(t, 0, 0); }
    __builtin_amdgcn_s_setprio(0);
#undef DA_ITER
    {
        const LAS unsigned char* vb = lds + ((NT - 1) & 1) * VBUF + vro;
        bf16x8 pf[4]; pf[0] = pack8(P0, 0); pf[1] = pack8(P0, 1); pf[2] = pack8(P1, 0); pf[3] = pack8(P1, 1);
#pragma unroll
        for (int sp = 0; sp < 4; ++sp) {
#pragma unroll
            for (int dvb = 0; dvb < 4; ++dvb) { const bf16x8 a = *(const LAS bf16x8*)(vb + dvb * 32 * VROW + sp * 32); O[dvb] = MFMA32(a, pf[sp], O[dvb]); }
            L = MFMA32(ones, pf[sp], L); }
    }
#undef DA_LOADK
#undef DA_LOADV
#undef DA_STOREK
#undef DA_STOREV
    __syncthreads();
    const float inv = __builtin_amdgcn_rcpf(L[0]);
    LAS float* ex = (LAS float*)lds;
    LAS float* sl = (LAS float*)(lds + 65536);
    if (tid < 128) sl[tid] = subln[tid];
    if (c == 1) {
#pragma unroll
        for (int dvb = 0; dvb < 4; ++dvb)
#pragma unroll
            for (int r = 0; r < 16; ++r) ex[((sub * 4 + dvb) * 16 + r) * 64 + lane] = O[dvb][r] * inv;
    }
    __syncthreads();
    if (c == 0) {
        float ss = 0.f;
#pragma unroll
        for (int dvb = 0; dvb < 4; ++dvb)
#pragma unroll
            for (int r = 0; r < 16; ++r) { const float o = O[dvb][r] * inv - lam * ex[((sub * 4 + dvb) * 16 + r) * 64 + lane]; O[dvb][r] = o; ss += o * o; }
        ss += __shfl_xor(ss, 32);
        const float rstd = __builtin_amdgcn_rsqf(ss * (1.f / 128.f) + EPS) * oscale;
        bf16_t* orow = YMb + (size_t)(q0 + 32 * sub + r32) * YMW + h * 128;
#pragma unroll
        for (int dvb = 0; dvb < 4; ++dvb)
#pragma unroll
            for (int rp = 0; rp < 2; ++rp) {
                u32x2 w[2];
#pragma unroll
                for (int q = 0; q < 2; ++q) { const int rg = 2 * rp + q; const int dv0 = 32 * dvb + 8 * rg + 4 * hi; const f32x4 g = *(const LAS f32x4*)(sl + dv0);
                    w[q].x = pk2(O[dvb][4 * rg] * rstd * g[0], O[dvb][4 * rg + 1] * rstd * g[1]); w[q].y = pk2(O[dvb][4 * rg + 2] * rstd * g[2], O[dvb][4 * rg + 3] * rstd * g[3]); }
                { auto r0 = __builtin_amdgcn_permlane32_swap(w[0].x, w[1].x, false, false); w[0].x = r0[0]; w[1].x = r0[1];
                  auto r1 = __builtin_amdgcn_permlane32_swap(w[0].y, w[1].y, false, false); w[0].y = r1[0]; w[1].y = r1[1]; }
                u32x4 o; o.x = w[0].x; o.y = w[0].y; o.z = w[1].x; o.w = w[1].y;
                *(u32x4*)(orow + 32 * dvb + 16 * rp + 8 * hi) = o; }
    }
    __syncthreads();
}
DI void kmax_item(LAS unsigned char* lds, const bf16_t* Yb, unsigned* kmaxp, int item) {
    const int tid = otid(), lane = tid & 63, wid = tid >> 6;
    const int hm = item / 33, rt = item % 33;
    const bf16_t* kp = Yb + (size_t)(rt * 256 + (tid >> 1)) * INW + (hm < 8 ? C_DK + hm * 64 : C_SK + (hm - 8) * 64) + (tid & 1) * 32;
    float ss = 0.f;
#pragma unroll
    for (int i = 0; i < 4; ++i) { const u32x4 w = *(const u32x4*)(kp + 8 * i);
        const float a0 = bflo(w.x), a1 = bfhi(w.x), a2 = bflo(w.y), a3 = bfhi(w.y), a4 = bflo(w.z), a5 = bfhi(w.z), a6 = bflo(w.w), a7 = bfhi(w.w);
        ss += (a0 * a0 + a1 * a1) + (a2 * a2 + a3 * a3) + (a4 * a4 + a5 * a5) + (a6 * a6 + a7 * a7); }
    ss += __shfl_xor(ss, 1);
#pragma unroll
    for (int o = 2; o < 64; o <<= 1) ss = fmaxf(ss, __shfl_xor(ss, o));
    LAS float* red = (LAS float*)lds;
    __syncthreads();
    if (lane == 0) red[wid] = ss;
    __syncthreads();
    if (tid == 0) { float mx = red[0];
#pragma unroll
        for (int w = 1; w < 8; ++w) mx = fmaxf(mx, red[w]);
        atomicMax(kmaxp + hm, __float_as_uint(sqrtf(mx))); }
}

DI void swa_unit(LAS unsigned char* lds, const bf16_t* Yb, bf16_t* YMb, int kvh, int qb, bool latent, const float* sink, const unsigned* kmaxp) {
    const int tid = otid(), lane = tid & 63, wid = __builtin_amdgcn_readfirstlane(tid >> 6), r32 = lane & 31, hi = lane >> 5;
    const int sub = wid & 1, hq = kvh * 4 + (wid >> 1);
    constexpr int ROW = 144, VOFF = 64 * ROW, BUF = 2 * 64 * ROW;
    const int q0 = latent ? CTX + 64 * qb : 64 * qb;
    const int srow = tid >> 3, spc = tid & 7;
    const int qpos = 64 * qb + 32 * sub + r32;
    const int wlo = 4 + (qb < 2 ? 2 - qb : 0), whi = latent ? 4 + (129 - qb < 4 ? 129 - qb : 4) : 3;
    bf16x8 qf[4];
    { const bf16_t* qp = Yb + (size_t)(q0 + 32 * sub + r32) * INW + C_SQ + hq * 64 + hi * 8;
#pragma unroll
      for (int d0 = 0; d0 < 4; ++d0) qf[d0] = *(const bf16x8*)(qp + 16 * d0); }
    float mub, l;
    { float ss = 0.f;
#pragma unroll
      for (int d0 = 0; d0 < 4; ++d0)
#pragma unroll
          for (int j = 0; j < 8; ++j) { const float v = __uint_as_float(((unsigned)(unsigned short)qf[d0][j]) << 16); ss += v * v; }
      ss += __shfl_xor(ss, 32);
      const float sk = sink[hq] * LOG2E;
      mub = fmaxf(sqrtf(ss) * __uint_as_float(kmaxp[8 + kvh]) * 1.01f, sk);
      l = hi == 0 ? ex2(sk - mub) : 0.f; }
    f32x16 O[2];
#pragma unroll
    for (int i = 0; i < 2; ++i)
#pragma unroll
        for (int r = 0; r < 16; ++r) O[i][r] = 0.f;
    u32x4 kv, vv;
#define SWA_LOAD(it_) do { const int kr_ = (it_) < 4 ? 64 * (it_) : CTX + 64 * qb - 128 + 64 * ((it_) - 4); \
        kv = *(const u32x4*)(Yb + (size_t)(kr_ + srow) * INW + C_SK + kvh * 64 + spc * 8); vv = *(const u32x4*)(Yb + (size_t)(kr_ + lane) * INW + C_SV + kvh * 64 + wid * 8); } while (0)
#define SWA_STORE(p_) do { *(LAS u32x4*)(lds + (p_) * BUF + srow * ROW + spc * 16) = kv; \
        LAS bf16_t* vt = (LAS bf16_t*)(lds + (p_) * BUF + VOFF) + wid * 8 * (ROW / 2) + lane; \
        vt[0 * (ROW / 2)] = (bf16_t)(vv.x & 0xffff); vt[1 * (ROW / 2)] = (bf16_t)(vv.x >> 16); vt[2 * (ROW / 2)] = (bf16_t)(vv.y & 0xffff); vt[3 * (ROW / 2)] = (bf16_t)(vv.y >> 16); \
        vt[4 * (ROW / 2)] = (bf16_t)(vv.z & 0xffff); vt[5 * (ROW / 2)] = (bf16_t)(vv.z >> 16); vt[6 * (ROW / 2)] = (bf16_t)(vv.w & 0xffff); vt[7 * (ROW / 2)] = (bf16_t)(vv.w >> 16); } while (0)
    SWA_LOAD(0); SWA_STORE(0);
    __syncthreads();
    int p = 0;
#pragma clang loop unroll(disable)
    for (int it = 0; it <= whi; it = (it == 3 ? wlo : it + 1)) {
        const int kp = 64 * qb - 128 + 64 * (it - 4);
        const int nx = it == 3 ? wlo : it + 1;
        if (nx <= whi) SWA_LOAD(nx);
        asm volatile("" ::: "memory");
        const LAS unsigned char* kb = lds + p * BUF + swap23(r32) * ROW + hi * 16;
        const LAS unsigned char* vb = lds + p * BUF + VOFF + r32 * ROW + hi * 16;
        f32x16 s0, s1;
#pragma unroll
        for (int r = 0; r < 16; ++r) { s0[r] = -mub; s1[r] = -mub; }
#pragma unroll
        for (int d0 = 0; d0 < 4; ++d0) { const bf16x8 k0 = *(const LAS bf16x8*)(kb + d0 * 32), k1 = *(const LAS bf16x8*)(kb + 32 * ROW + d0 * 32); s0 = MFMA32(k0, qf[d0], s0); s1 = MFMA32(k1, qf[d0], s1); }
        if (it >= 4) {
            const int dbase = kp + 8 * hi - qpos;
#pragma unroll
            for (int r = 0; r < 16; ++r) { const int d0 = dbase + (r & 3) + 4 * ((r >> 2) & 1) + 16 * ((r >> 3) & 1), d1 = d0 + 32;
                if (d0 > 128 || d0 < -128) s0[r] = -INFINITY; if (d1 > 128 || d1 < -128) s1[r] = -INFINITY; }
        }
        float ps = 0.f;
#pragma unroll
        for (int r = 0; r < 16; ++r) { s0[r] = ex2(s0[r]); s1[r] = ex2(s1[r]); ps += s0[r] + s1[r]; }
        l += ps;
        bf16x8 pf[4]; pf[0] = pack8(s0, 0); pf[1] = pack8(s0, 1); pf[2] = pack8(s1, 0); pf[3] = pack8(s1, 1);
#pragma unroll
        for (int dvb = 0; dvb < 2; ++dvb)
#pragma unroll
            for (int sp = 0; sp < 4; ++sp) { const bf16x8 a = *(const LAS bf16x8*)(vb + dvb * 32 * ROW + sp * 32); O[dvb] = MFMA32(a, pf[sp], O[dvb]); }
        if (nx <= whi) SWA_STORE(p ^ 1);
        __syncthreads();
        p ^= 1;
    }
#undef SWA_LOAD
#undef SWA_STORE
    const float lt = l + __shfl_xor(l, 32);
    const float inv = __builtin_amdgcn_rcpf(lt);
    bf16_t* orow = YMb + (size_t)(q0 + 32 * sub + r32) * YMW + 1024 + hq * 64;
#pragma unroll
    for (int dvb = 0; dvb < 2; ++dvb)
#pragma unroll
        for (int rg = 0; rg < 4; ++rg) { const int dv0 = 32 * dvb + 8 * rg + 4 * hi;
            u32x2 w; w.x = pk2(O[dvb][4 * rg] * inv, O[dvb][4 * rg + 1] * inv); w.y = pk2(O[dvb][4 * rg + 2] * inv, O[dvb][4 * rg + 3] * inv);
            *(u32x2*)(orow + dv0) = w; }
}

DI int hgrn_chunk(int mb, int dir) { return dir == 0 ? mb : (mb < 4 ? 3 - mb : 135 - mb); }
DI void hgrn_pass1_unit(LAS unsigned char* lds, const bf16_t* LOGF  , const bf16_t* VTb, bf16_t* G, float* DEC, int h, int mb) {
    const int tid = otid(), lane = tid & 63, wid = __builtin_amdgcn_readfirstlane(tid >> 6), r32 = lane & 31, hi = lane >> 5;
    LAS float* LB = (LAS float*)lds;
    constexpr int VTO = 65536, VROW = 144, KTO = VTO + 128 * VROW, KTB = 128 * VROW;
#pragma unroll
    for (int i = 0; i < 4; ++i) { const int idx = tid + NTHR * i, dir = idx >> 10, rem = idx & 1023, s = rem >> 4, k8 = rem & 15;
        const u32x4 w = *(const u32x4*)(LOGF + (size_t)(64 * mb + s) * INW + C_FF + dir * 512 + h * 128 + 8 * k8);
        LAS float* dst = LB + (dir * 64 + s) * 128 + 8 * k8;
        *(LAS f32x4*)dst = (f32x4){bflo(w.x), bfhi(w.x), bflo(w.y), bfhi(w.y)}; *(LAS f32x4*)(dst + 4) = (f32x4){bflo(w.z), bfhi(w.z), bflo(w.w), bfhi(w.w)}; }
#pragma unroll
    for (int i = 0; i < 2; ++i) { const int pc = tid + NTHR * i, v = pc >> 3, c8 = pc & 7;
        *(LAS u32x4*)(lds + VTO + v * VROW + c8 * 16) = *(const u32x4*)(VTb + (size_t)(512 + h * 128 + v) * RB + 64 * mb + 8 * c8); }
    __syncthreads();
    if (tid < 256) { const int dir = tid >> 7, k = tid & 127; float a = 0.f;
        LAS float* lb = LB + dir * 64 * 128 + k; float v[64];
#pragma unroll
        for (int s = 0; s < 64; ++s) v[s] = lb[s * 128];
        if (dir == 0) {
#pragma unroll
            for (int s = 0; s < 64; ++s) { a += v[s]; v[s] = a; } }
        else {
#pragma unroll
            for (int s = 63; s >= 0; --s) { a += v[s]; v[s] = a; } }
#pragma unroll
        for (int s = 0; s < 64; ++s) lb[s * 128] = v[s];
        DEC[((size_t)(h * 2 + dir) * NCH + hgrn_chunk(mb, dir)) * 128 + k] = fexp(a); }
    __syncthreads();
    { const int dir = tid >> 8, k = tid & 127, sh = (tid >> 7) & 1;
      const LAS float* lb = LB + dir * 64 * 128 + k;
      const float bl = dir == 0 ? lb[63 * 128] : lb[0];
      LAS unsigned* kt = (LAS unsigned*)(lds + KTO + dir * KTB + k * VROW);
#pragma unroll 4
      for (int sp = 0; sp < 16; ++sp) { const int s = 32 * sh + 2 * sp;
          const float b0 = lb[s * 128], b1 = lb[(s + 1) * 128];
          float lf0, lf1;
          if (dir == 0) { lf0 = s == 0 ? b0 : b0 - lb[(s - 1) * 128]; lf1 = b1 - b0; }
          else { lf1 = s + 1 == 63 ? b1 : b1 - lb[(s + 2) * 128]; lf0 = b0 - b1; }
          const float k0 = (1.f - fexp(lf0)) * fexp(bl - b0), k1 = (1.f - fexp(lf1)) * fexp(bl - b1);
          kt[s >> 1] = pk2(k0, k1); } }
    __syncthreads();
    { const int dir = wid >> 2, vb = wid & 3;
      f32x16 acc[4];
#pragma unroll
      for (int i = 0; i < 4; ++i)
#pragma unroll
          for (int r = 0; r < 16; ++r) acc[i][r] = 0.f;
      const LAS unsigned char* va = lds + VTO + (32 * vb + r32) * VROW + hi * 16;
      const LAS unsigned char* ka = lds + KTO + dir * KTB + r32 * VROW + hi * 16;
#pragma unroll
      for (int st = 0; st < 4; ++st) { const bf16x8 a = *(const LAS bf16x8*)(va + st * 32);
#pragma unroll
          for (int kb = 0; kb < 4; ++kb) { const bf16x8 b = *(const LAS bf16x8*)(ka + kb * 32 * VROW + st * 32); acc[kb] = MFMA32(a, b, acc[kb]); } }
      bf16_t* g = G + ((size_t)(h * 2 + dir) * NCH + hgrn_chunk(mb, dir)) * 16384;
#pragma unroll
      for (int kb = 0; kb < 4; ++kb)
#pragma unroll
          for (int r = 0; r < 16; ++r) { const int v = 32 * vb + (r & 3) + 8 * (r >> 2) + 4 * hi; g[v * 128 + 32 * kb + r32] = (bf16_t)(pk2(acc[kb][r], 0.f) & 0xffffu); } }
    __syncthreads();
}
DI void hgrn_pass2(const bf16_t* G, const float* DEC, bf16_t* ST, int e0, int e1, int tid) {
    for (int e = e0 + 2 * tid; e < e1; e += 2 * NTHR) {
        const int ch = e >> 14, vk = e & 16383, k = vk & 127;
        const bf16_t* g = G + (size_t)ch * NCH * 16384 + vk; const float* d = DEC + (size_t)ch * NCH * 128 + k; bf16_t* st = ST + (size_t)ch * NCH * 16384 + vk;
        float S0 = 0.f, S1 = 0.f;
        for (int n0 = 0; n0 < NCH; n0 += 33) {
            unsigned gv[33]; f32x2 dv[33];
#pragma unroll
            for (int j = 0; j < 33; ++j) { gv[j] = *(const unsigned*)(g + (size_t)(n0 + j) * 16384); dv[j] = *(const f32x2*)(d + (n0 + j) * 128); }
#pragma unroll
            for (int j = 0; j < 33; ++j) { *(unsigned*)(st + (size_t)(n0 + j) * 16384) = pk2(S0, S1); S0 = dv[j][0] * S0 + bflo(gv[j]); S1 = dv[j][1] * S1 + bfhi(gv[j]); }
        }
    }
}
DI void hgrn_pass3_unit(LAS unsigned char* lds, const bf16_t* Yb, const float* LOGF, const bf16_t* VTb, const bf16_t* ST, bf16_t* YMb, const float* hnorm, int h, int mb) {
    const int tid = otid(), lane = tid & 63, wid = __builtin_amdgcn_readfirstlane(tid >> 6), r32 = lane & 31, hi = lane >> 5;
    LAS float* LB = (LAS float*)lds;
    constexpr int PR = 272, QHO = 32768, KHO = QHO + 64 * PR, STO = KHO + 64 * PR, VTO = STO + 128 * PR, VROW = 144, ATO = VTO + 128 * VROW, SSO = ATO + 64 * VROW;
    const int tb = wid & 1, vb = wid >> 1;
    f32x16 acc;
#pragma unroll
    for (int r = 0; r < 16; ++r) acc[r] = 0.f;
#pragma unroll
    for (int i = 0; i < 2; ++i) { const int pc = tid + NTHR * i, v = pc >> 3, c8 = pc & 7;
        *(LAS u32x4*)(lds + VTO + v * VROW + c8 * 16) = *(const u32x4*)(VTb + (size_t)(512 + h * 128 + v) * RB + 64 * mb + 8 * c8); }
#pragma unroll 1
    for (int dir = 0; dir < 2; ++dir) {
        u32x4 lg[2]; u32x4 qq0, qq1, stv[4];
#pragma unroll
        for (int i = 0; i < 2; ++i) { const int idx = tid + NTHR * i, s = idx >> 4, k8 = idx & 15;
            lg[i] = *(const u32x4*)(Yb + (size_t)(64 * mb + s) * INW + C_FF + dir * 512 + h * 128 + 8 * k8); }
        { const bf16_t* qp = Yb + (size_t)(64 * mb + (tid >> 3)) * INW + C_HQ + h * 128 + 16 * (tid & 7); qq0 = *(const u32x4*)qp; qq1 = *(const u32x4*)(qp + 8); }
        { const bf16_t* st = ST + ((size_t)(h * 2 + dir) * NCH + hgrn_chunk(mb, dir)) * 16384;
#pragma unroll
          for (int i = 0; i < 4; ++i) { const int pc = tid + NTHR * i; stv[i] = *(const u32x4*)(st + (pc >> 4) * 128 + (pc & 15) * 8); } }
        asm volatile("" ::: "memory");
        __syncthreads();
#pragma unroll
        for (int i = 0; i < 2; ++i) { const int idx = tid + NTHR * i, s = idx >> 4, k8 = idx & 15; const u32x4 w = lg[i];
            LAS float* dst = LB + s * 128 + 8 * k8;
            *(LAS f32x4*)dst = (f32x4){bflo(w.x), bfhi(w.x), bflo(w.y), bfhi(w.y)}; *(LAS f32x4*)(dst + 4) = (f32x4){bflo(w.z), bfhi(w.z), bflo(w.w), bfhi(w.w)}; }
        __syncthreads();
        if (tid < 128) { float a = 0.f; LAS float* lb = LB + tid; float v[64];
#pragma unroll
            for (int s = 0; s < 64; ++s) v[s] = lb[s * 128];
            if (dir == 0) {
#pragma unroll
                for (int s = 0; s < 64; ++s) { a += v[s]; v[s] = a; } }
            else {
#pragma unroll
                for (int s = 63; s >= 0; --s) { a += v[s]; v[s] = a; } }
#pragma unroll
            for (int s = 0; s < 64; ++s) lb[s * 128] = v[s]; }
        __syncthreads();
        const int mid = dir == 0 ? 31 : 32;
        { const int s = tid >> 3, kc = tid & 7;
          const u32x4 q0 = qq0, q1 = qq1;
          float qv[16] = {bflo(q0.x), bfhi(q0.x), bflo(q0.y), bfhi(q0.y), bflo(q0.z), bfhi(q0.z), bflo(q0.w), bfhi(q0.w), bflo(q1.x), bfhi(q1.x), bflo(q1.y), bfhi(q1.y), bflo(q1.z), bfhi(q1.z), bflo(q1.w), bfhi(q1.w)};
          float qh[16], kh[16];
          const int sn = dir == 0 ? s - 1 : s + 1; const bool edge = dir == 0 ? (s == 0) : (s == 63);
#pragma unroll
          for (int j4 = 0; j4 < 4; ++j4) { const f32x4 b = *(const LAS f32x4*)(LB + s * 128 + 16 * kc + 4 * j4), rr = *(const LAS f32x4*)(LB + mid * 128 + 16 * kc + 4 * j4);
              f32x4 bn = {0.f, 0.f, 0.f, 0.f}; if (!edge) bn = *(const LAS f32x4*)(LB + sn * 128 + 16 * kc + 4 * j4);
#pragma unroll
              for (int j = 0; j < 4; ++j) { const float lf = b[j] - bn[j]; qh[4 * j4 + j] = qv[4 * j4 + j] * fexp(fminf(b[j] - rr[j], 80.f)); kh[4 * j4 + j] = (1.f - fexp(lf)) * fexp(fminf(rr[j] - b[j], 80.f)); } }
          u32x4 w0, w1;
          w0.x = pk2(qh[0], qh[1]); w0.y = pk2(qh[2], qh[3]); w0.z = pk2(qh[4], qh[5]); w0.w = pk2(qh[6], qh[7]); w1.x = pk2(qh[8], qh[9]); w1.y = pk2(qh[10], qh[11]); w1.z = pk2(qh[12], qh[13]); w1.w = pk2(qh[14], qh[15]);
          *(LAS u32x4*)(lds + QHO + s * PR + kc * 32) = w0; *(LAS u32x4*)(lds + QHO + s * PR + kc * 32 + 16) = w1;
          w0.x = pk2(kh[0], kh[1]); w0.y = pk2(kh[2], kh[3]); w0.z = pk2(kh[4], kh[5]); w0.w = pk2(kh[6], kh[7]); w1.x = pk2(kh[8], kh[9]); w1.y = pk2(kh[10], kh[11]); w1.z = pk2(kh[12], kh[13]); w1.w = pk2(kh[14], kh[15]);
          *(LAS u32x4*)(lds + KHO + s * PR + kc * 32) = w0; *(LAS u32x4*)(lds + KHO + s * PR + kc * 32 + 16) = w1; }
        {
#pragma unroll
          for (int i = 0; i < 4; ++i) { const int pc = tid + NTHR * i, v = pc >> 4, k8 = pc & 15;
              const u32x4 sv = stv[i];
              const f32x4 r0 = *(const LAS f32x4*)(LB + mid * 128 + 8 * k8), r1 = *(const LAS f32x4*)(LB + mid * 128 + 8 * k8 + 4);
              u32x4 w; w.x = pk2(bflo(sv.x) * fexp(r0[0]), bfhi(sv.x) * fexp(r0[1])); w.y = pk2(bflo(sv.y) * fexp(r0[2]), bfhi(sv.y) * fexp(r0[3]));
              w.z = pk2(bflo(sv.z) * fexp(r1[0]), bfhi(sv.z) * fexp(r1[1])); w.w = pk2(bflo(sv.w) * fexp(r1[2]), bfhi(sv.w) * fexp(r1[3]));
              *(LAS u32x4*)(lds + STO + v * PR + k8 * 16) = w; } }
        __syncthreads();
        if (wid < 4) { const int sb = wid & 1, tb2 = wid >> 1;
            f32x16 a;
#pragma unroll
            for (int r = 0; r < 16; ++r) a[r] = 0.f;
            const LAS unsigned char* ka = lds + KHO + (32 * sb + r32) * PR + hi * 16;
            const LAS unsigned char* qa = lds + QHO + (32 * tb2 + r32) * PR + hi * 16;
#pragma unroll
            for (int kk = 0; kk < 8; ++kk) a = MFMA32(*(const LAS bf16x8*)(ka + kk * 32), *(const LAS bf16x8*)(qa + kk * 32), a);
            const int t = 32 * tb2 + r32;
#pragma unroll
            for (int rg = 0; rg < 4; ++rg) { const int s0 = 32 * sb + 8 * rg + 4 * hi; float v4[4];
#pragma unroll
                for (int j = 0; j < 4; ++j) { const int s = s0 + j; const bool keep = dir == 0 ? (s <= t) : (s >= t); v4[j] = keep ? a[4 * rg + j] : 0.f; }
                u32x2 w; w.x = pk2(v4[0], v4[1]); w.y = pk2(v4[2], v4[3]); *(LAS u32x2*)(lds + ATO + t * VROW + s0 * 2) = w; } }
        __syncthreads();
        { const LAS unsigned char* va = lds + VTO + (32 * vb + r32) * VROW + hi * 16;
          const LAS unsigned char* aa = lds + ATO + (32 * tb + r32) * VROW + hi * 16;
#pragma unroll
          for (int st = 0; st < 4; ++st) acc = MFMA32(*(const LAS bf16x8*)(va + st * 32), *(const LAS bf16x8*)(aa + st * 32), acc);
          const LAS unsigned char* sa = lds + STO + (32 * vb + r32) * PR + hi * 16;
          const LAS unsigned char* qa = lds + QHO + (32 * tb + r32) * PR + hi * 16;
#pragma unroll
          for (int kk = 0; kk < 8; ++kk) acc = MFMA32(*(const LAS bf16x8*)(sa + kk * 32), *(const LAS bf16x8*)(qa + kk * 32), acc); }
    }
    LAS float* SS = (LAS float*)(lds + SSO);
    { float ss = 0.f;
#pragma unroll
      for (int r = 0; r < 16; ++r) ss += acc[r] * acc[r];
      ss += __shfl_xor(ss, 32);
      if (hi == 0) SS[vb * 64 + 32 * tb + r32] = ss; }
    __syncthreads();
    { const int t = 32 * tb + r32; const float tot = SS[t] + SS[64 + t] + SS[128 + t] + SS[192 + t];
      const float rstd = __builtin_amdgcn_rsqf(tot * (1.f / 128.f) + EPS);
      const bf16_t* gp = Yb + (size_t)(64 * mb + t) * INW + C_HG + h * 128;
      bf16_t* op = YMb + (size_t)(64 * mb + t) * YMW + 512 + h * 128;
#pragma unroll
      for (int rg = 0; rg < 4; ++rg) { const int v0 = 32 * vb + 8 * rg + 4 * hi; const u32x2 gw = *(const u32x2*)(gp + v0); const f32x4 nw = *(const f32x4*)(hnorm + v0);
          u32x2 w; w.x = pk2(acc[4 * rg] * rstd * nw[0] * bflo(gw.x), acc[4 * rg + 1] * rstd * nw[1] * bfhi(gw.x));
          w.y = pk2(acc[4 * rg + 2] * rstd * nw[2] * bflo(gw.y), acc[4 * rg + 3] * rstd * nw[3] * bfhi(gw.y));
          *(u32x2*)(op + v0) = w; } }
    __syncthreads();
}


#define XB_TMO      128
#define XB_XCNT(j)  (256  + 64 * (j))
#define XB_XSUB(j)  (1280 + 64 * (j))
#define XB_XGEN(j)  (2304 + 64 * (j))
#define XB_TOP      3328
#define XB_TOPGEN   3392
#define XCD_BAR_WORDS 3456
#define XB_SPIN_CAP (1u << 22)
DI unsigned xb_ld(unsigned* p)              { return __hip_atomic_load(p, __ATOMIC_RELAXED, __HIP_MEMORY_SCOPE_AGENT); }
DI unsigned xb_add(unsigned* p, unsigned v) { return __hip_atomic_fetch_add(p, v, __ATOMIC_RELAXED, __HIP_MEMORY_SCOPE_AGENT); }
DI unsigned xb_xcc_id() { return (unsigned)__builtin_amdgcn_s_getreg((3 << 11) | 20) & 0xFu; }
#define XB_SPIN(cond, bar) do { unsigned _sp = 0; while (cond) { __builtin_amdgcn_s_sleep(3); \
    if ((++_sp & 255u) == 0u) { if (xb_ld(&(bar)[XB_TMO])) break; if (_sp > XB_SPIN_CAP) { atomicAdd(&(bar)[XB_TMO], 1u); break; } } } } while (0)
struct XcdBarrier { unsigned* bar; unsigned x; volatile LAS unsigned* st; };
DI XcdBarrier xcd_barrier_post(unsigned* bar, volatile LAS unsigned* st) {
    XcdBarrier b; b.bar = bar; b.x = xb_xcc_id(); b.st = st;
    if (threadIdx.x == 0) (void)xb_add(&bar[XB_XCNT(b.x)], 1u);
    return b;
}
DI void xcd_barrier_complete(unsigned* bar, unsigned x, unsigned& nloc, unsigned& nx) {
    const unsigned G = gridDim.x * gridDim.y * gridDim.z;
    unsigned sum, cnt, mine, sp = 0u;
    for (;;) {
        sum = 0u; cnt = 0u; mine = 0u;
#pragma unroll
        for (unsigned j = 0; j < 16; ++j) { const unsigned c = xb_ld(&bar[XB_XCNT(j)]); sum += c; cnt += (c > 0u) ? 1u : 0u; mine = (j == x) ? c : mine; }
        if (sum == G) break;
        __builtin_amdgcn_s_sleep(1);
        if ((++sp & 255u) == 0u) { if (xb_ld(&bar[XB_TMO])) break; if (sp > XB_SPIN_CAP) { atomicAdd(&bar[XB_TMO], 1u); break; } }
    }
    nloc = mine > 0u ? mine : 1u; nx = cnt > 0u ? cnt : 1u;
}
DI void xcd_barrier(const XcdBarrier& b) {
    asm volatile("s_waitcnt vmcnt(0)" ::: "memory");
    __syncthreads();
    if (threadIdx.x == 0) {
        unsigned* bar = b.bar;
        __builtin_amdgcn_s_waitcnt(0);
        unsigned nloc = b.st[0], nx = b.st[1];
        if (nloc == 0u) { xcd_barrier_complete(bar, b.x, nloc, nx); b.st[0] = nloc; b.st[1] = nx; }
        const unsigned old = xb_add(&bar[XB_XSUB(b.x)], 1u);
        const unsigned gen = old / nloc;
        if (old + 1u == (gen + 1u) * nloc) {
            __builtin_amdgcn_fence(__ATOMIC_RELEASE, "agent");
            asm volatile("s_waitcnt vmcnt(0)" ::: "memory");
            const unsigned og = xb_add(&bar[XB_TOP], 1u);
            const unsigned tg = og / nx;
            if (og + 1u == (tg + 1u) * nx) xb_add(&bar[XB_TOPGEN], 1u);
            else XB_SPIN(xb_ld(&bar[XB_TOPGEN]) == tg, bar);
            __builtin_amdgcn_fence(__ATOMIC_ACQUIRE, "agent");
            xb_add(&bar[XB_XGEN(b.x)], 1u);
            asm volatile("s_waitcnt vmcnt(0)" ::: "memory");
        } else {
            XB_SPIN(xb_ld(&bar[XB_XGEN(b.x)]) == gen, bar);
            __builtin_amdgcn_fence(__ATOMIC_ACQUIRE, "agent");
            asm volatile("s_waitcnt vmcnt(0)" ::: "memory");
        }
    }
    __syncthreads();
}

struct Args { Ptrs P; int ph_lo, ph_hi; };
constexpr int N_PHASES = 2 + DEPTH * 21;

__global__ void __launch_bounds__(NTHR, 2) fwd_kernel(Args args) {
    extern __shared__ __attribute__((aligned(16))) unsigned char lds_raw[];
    LAS unsigned char* lds = (LAS unsigned char*)lds_raw;
    const Ptrs& P = args.P;
    unsigned char* ws = P.ws;
    float* MODS = (float*)(ws + WS_MODS); float* cosT = (float*)(ws + WS_ROPE); float* sinT = cosT + 2048;
    float* CTXR = (float*)(ws + WS_CTXR);
    bf16_t* Wb = (bf16_t*)(ws + WS_W);
    bf16_t* Hb = (bf16_t*)(ws + WS_H); bf16_t* MG = (bf16_t*)(ws + WS_MG);
    unsigned char* big = ws + WS_BIG;
    bf16_t* Yb = (bf16_t*)(big + WB_Y); float* LOGF = (float*)(big + WB_LOGF); bf16_t* VTb = (bf16_t*)(big + WB_VT);
    bf16_t* Gs = (bf16_t*)(big + WB_G); bf16_t* STb = (bf16_t*)(big + WB_ST); float* DEC = (float*)(big + WB_DEC); bf16_t* YMb = (bf16_t*)(big + WB_YM);
    bf16_t* YOUT = (bf16_t*)(big); bf16_t* Ub = (bf16_t*)(big); bf16_t* Zb = MG;
    const int lo = args.ph_lo, hi = args.ph_hi;
    cg::grid_group grid = cg::this_grid();
    volatile LAS unsigned* bst = (volatile LAS unsigned*)(lds + LDS_BYTES - 64);
    if (threadIdx.x < 2) bst[threadIdx.x] = 0u;
    __syncthreads();
    XcdBarrier xbar; xbar.bar = (unsigned*)(ws + WS_BAR); xbar.x = 0; xbar.st = bst;
    if (hi - lo > 1) xbar = xcd_barrier_post((unsigned*)(ws + WS_BAR), bst);
#pragma clang loop unroll(disable)
    for (int ph = lo; ph < hi; ++ph) {
        int l = 0, b = 0, kind = 0;
        if (ph == 1) kind = 1;
        else if (ph > 1) { const int q = ph - 2; l = q / 21; const int r = q % 21;
            if (r < 16) { b = r >> 2; const int i = r & 3; kind = i < 2 ? 2 + i : 3 + i; } else kind = 7 + (r - 16); }
        asm volatile("" : "+s"(l), "+s"(b), "+s"(kind));
        const int tid = otid(), lane = tid & 63, wave = __builtin_amdgcn_readfirstlane(tid >> 6);
        int G = gridDim.x, bx = blockIdx.x; asm volatile("" : "+s"(G), "+s"(bx));
        const int gw = bx * 8 + wave, ngw = G * 8;
        const float* ng = P.norm_g + (size_t)l * 4 * DM;
        if (kind == 0) {
            if (bx == G - 1) { for (int i = tid; i < 2048; i += NTHR) { const int pos = i >> 4, f = i & 15; const float inv = ex2(-(float)f * (13.287712379549449f / 16.f)); const float ang = (float)pos * inv; cosT[i] = __cosf(ang); sinT[i] = __sinf(ang); } }
            for (int it = bx; it < 192; it += G) mods_item(P, it, lds, tid, wave, lane);
            __syncthreads();
            convert_weights(P, 0, lds, gw, ngw, wave, lane);
        } else if (kind == 1) {
            if (l == 0) {
                for (int R = gw; R < MT; R += ngw) { const int bb = R / RB, p = R % RB; const float* md = MODS + (size_t)(p < CTX ? 4 : bb) * 6144;
                    const float* src = p < CTX ? P.ctx + ((size_t)bb * CTX + p) * DM : P.x + ((size_t)bb * SEQ + (p - CTX)) * DM;
                    row_update<0>(src, nullptr, nullptr, nullptr, nullptr, ng, md, md + 1024, Hb + (size_t)R * DM, lane); }
            }
        } else if (kind == 2) {
            SchedWin S{(const char*)(Hb + (size_t)b * RB * DM), (const char*)(Wb + WO_IN / 2), G, bx};
            EpiWin E{Yb, LOGF, VTb, cosT, sinT, P.hgrn_lb, l};
            pg8::gemm_phase(lds, pg8::GemmDesc{DM, DM, DM}, S, E);
        } else if (kind == 3) {
                        for (int it = bx; it < 330; it += G) kmax_item(lds, Yb, (unsigned*)(ws + WS_BAR) + 5120 + (l * NB + b) * 16, it);
            __syncthreads();
#pragma clang loop unroll(disable)
            for (int v = bx; v < 4 * NCH; v += G) hgrn_pass1_unit(lds, Yb, VTb, Gs, DEC, v / NCH, v % NCH);
        } else if (kind == 5) {
            const float* dl = P.diff_lambda + l * 256;
            const float lam_init = l == 0 ? 0.2f : 0.35550906758f;
            const float lam = fexp(wave_sum(dl[lane] * dl[64 + lane])) - fexp(wave_sum(dl[128 + lane] * dl[192 + lane])) + lam_init;
            unsigned* sflag = (unsigned*)(ws + WS_BAR) + 4096 + 64 * (l * NB + b);
            for (int su = G - 1 - bx; su < 128; su += G) {
                hgrn_pass2(Gs, DEC, STb, su * 1024, su * 1024 + 1024, tid);
                asm volatile("s_waitcnt vmcnt(0)" ::: "memory");
                __syncthreads();
                if (tid == 0) { __builtin_amdgcn_fence(__ATOMIC_RELEASE, "agent"); asm volatile("s_waitcnt vmcnt(0)" ::: "memory"); xb_add(sflag, 1u); }
            }
            const int nl = bx < 256 ? (255 - bx) / G + 1 : 0;
#pragma clang loop unroll(disable)
            for (int k = 0; k < nl + 8; ++k) {
                int u; bool lat = true;
                if (k < nl) u = bx + k * G; else { const int v = k - nl; if ((120 + v) % G != bx) continue; u = v; lat = false; }
                const int uu = lat ? ((((u & 7) >> 1) << 6) | ((u & 1) << 5) | (u >> 3)) : u;
                diff_attn_unit(lds, Yb, VTb, YMb, lat ? (uu >> 6) : (uu >> 1), lat ? CTX + 128 * (uu & 63) : 128 * (uu & 1), lat ? RB : CTX, lam, P.diff_subln + l * 128, 1.f - lam_init, (const unsigned*)(ws + WS_BAR) + 5120 + (l * NB + b) * 16);
            }
            {   const int nls = bx < 256 ? (255 - bx) / G + 1 : 0;
#pragma clang loop unroll(disable)
                for (int k = 0; k < nls + 8; ++k) {
                    int u; if (k < nls) u = bx + k * G; else { const int e = k - nls; if (G - 1 - (16 + e) % G != bx) continue; u = 256 + e; }
                    const bool lat = u < 256; const int vv = lat ? u : u - 256;
                    swa_unit(lds, Yb, YMb, lat ? (vv >> 7) : (vv >> 2), lat ? (vv & 127) : (vv & 3), lat, P.swa_sink + l * 8, (const unsigned*)(ws + WS_BAR) + 5120 + (l * NB + b) * 16); } }
            {   if (tid == 0) { unsigned sp = 0; while (xb_ld(sflag) < 128u) { __builtin_amdgcn_s_sleep(4); if (++sp > (1u << 24)) break; }
                    __builtin_amdgcn_fence(__ATOMIC_ACQUIRE, "agent"); asm volatile("s_waitcnt vmcnt(0)" ::: "memory"); }
                __syncthreads(); }
#pragma clang loop unroll(disable)
            for (int v = bx; v < 4 * NCH; v += G) hgrn_pass3_unit(lds, Yb, LOGF, VTb, STb, YMb, P.hgrn_norm + l * 128, v / NCH, v % NCH);
        } else if (kind == 6) {
            SchedMerge S{(const char*)YMb, (const char*)(Wb + WO_BR / 2), bx};
            EpiMerge E{Yb, Gs, MG + (size_t)b * RB * DM};
            pg8::gemm_phase(lds, pg8::GemmDesc{YMW, 512, 512}, S, E);
        } else if (kind == 7) {
            const bool sk = l == DEPTH - 1; SchedPlain S{(const char*)MG, (const char*)(Wb + WO_OUT / 2), sk ? 128 : MT / 256, DM / 256, DM, G, bx, sk};
            EpiStore<1> E{(void*)YOUT, DM};
            pg8::gemm_phase(lds, pg8::GemmDesc{DM, DM, DM}, S, E);
        } else if (kind == 8) {
            for (int R = gw; R < MT; R += ngw) { const int bb = R / RB, p = R % RB; const float* md = MODS + (size_t)(l * 5 + (p < CTX ? 4 : bb)) * 6144;
                if (l == DEPTH - 1 && p < CTX) continue;
                const float* rin; float* rout;
                if (p < CTX) { rout = CTXR + ((size_t)bb * CTX + p) * DM; rin = l == 0 ? P.ctx + ((size_t)bb * CTX + p) * DM : rout; }
                else { rout = P.out + ((size_t)bb * SEQ + (p - CTX)) * DM; rin = l == 0 ? P.x + ((size_t)bb * SEQ + (p - CTX)) * DM : rout; }
                row_update<2>(rin, rout, YOUT + (size_t)R * DM, md + 2048, ng + DM, ng + 2 * DM, md + 3072, md + 4096, Hb + (size_t)R * DM, lane); }
        } else if (kind == 9) {
            const bool sk = l == DEPTH - 1; SchedPlain S{(const char*)Hb, (const char*)(Wb + WO_UP / 2), sk ? 128 : MT / 256, FF / 256, DM, G, bx, sk};
            EpiStore<2> E{(void*)Ub, FF};
            pg8::gemm_phase(lds, pg8::GemmDesc{DM, DM, DM}, S, E);
        } else if (kind == 10) {
            const bool sk = l == DEPTH - 1; SchedPlain S{(const char*)Ub, (const char*)(Wb + WO_DN / 2), sk ? 128 : MT / 256, DM / 256, FF, G, bx, sk};
            EpiStore<1> E{(void*)Zb, DM};
            pg8::gemm_phase(lds, pg8::GemmDesc{FF, FF, FF}, S, E);
        } else {
            const bool more = l + 1 < DEPTH;
            const float* ngn = P.norm_g + (size_t)(more ? l + 1 : l) * 4 * DM;
            for (int R = gw; R < MT; R += ngw) { const int bb = R / RB, p = R % RB; const int vsel = p < CTX ? 4 : bb; const float* md = MODS + (size_t)(l * 5 + vsel) * 6144;
                if (!more && p < CTX) continue;
                float* rr = p < CTX ? CTXR + ((size_t)bb * CTX + p) * DM : P.out + ((size_t)bb * SEQ + (p - CTX)) * DM;
                const float* mdn = MODS + (size_t)((more ? l + 1 : l) * 5 + vsel) * 6144;
                row_update<2>(rr, rr, Zb + (size_t)R * DM, md + 5120, ng + 3 * DM, ngn, mdn, mdn + 1024, more ? Hb + (size_t)R * DM : nullptr, lane); }
            if (more) { __syncthreads(); convert_weights(P, l + 1, lds, gw, ngw, wave, lane); }
        }
        if (ph + 1 < hi) { if (hi < 0) grid.sync(); else xcd_barrier(xbar); }
    }
}

extern "C" void kernel_launch(void* const* d_in, const int* in_sizes, int n_in, void* d_out, int out_size, void* d_ws, size_t ws_size, hipStream_t stream) {
    static int grid = 0;
    if (grid == 0) {
        if (n_in != 17 || ws_size < WS_END) { fprintf(stderr, "kernel_launch: unexpected inputs (n_in %d, ws %zu, need %zu)\n", n_in, ws_size, (size_t)WS_END); grid = -1; return; }
        int dev = 0, cus = 0, per_cu = 0;
        hipGetDevice(&dev); hipDeviceGetAttribute(&cus, hipDeviceAttributeMultiprocessorCount, dev);
        hipFuncSetAttribute((const void*)fwd_kernel, hipFuncAttributeMaxDynamicSharedMemorySize, LDS_BYTES);
        hipOccupancyMaxActiveBlocksPerMultiprocessor(&per_cu, (const void*)fwd_kernel, NTHR, LDS_BYTES);
        if (per_cu < 1) per_cu = 1;
        (void)hipGetLastError();
        grid = cus * 1;
        if (grid > 256) grid = 256;
    }
    if (grid < 0) return;
    Args a{};
    const float** pp = (const float**)&a.P;
    for (int i = 0; i < 17; ++i) pp[i] = (const float*)d_in[i];
    a.P.out = (float*)d_out; a.P.ws = (unsigned char*)d_ws;
    (void)hipMemsetAsync((char*)d_ws + WS_BAR, 0, 32768, stream);
#if MK_ONE_LAUNCH
    a.ph_lo = 0; a.ph_hi = N_PHASES;
    void* kargs[] = {&a};
    hipError_t e = hipLaunchCooperativeKernel((const void*)fwd_kernel, dim3(grid), dim3(NTHR), kargs, LDS_BYTES, stream);
    if (e != hipSuccess) fprintf(stderr, "cooperative launch failed: %s (grid %d)\n", hipGetErrorString(e), grid);
#else
    for (int p = 0; p < N_PHASES; ++p) { a.ph_lo = p; a.ph_hi = p + 1; hipLaunchKernelGGL(fwd_kernel, dim3(grid), dim3(NTHR), LDS_BYTES, stream, a); }
#endif
}
```

```cpp
#include <hip/hip_runtime.h>
#include <hip/hip_cooperative_groups.h>
#include <cstdio>
#include <cstdint>
namespace cg = cooperative_groups;

#ifndef MK_ONE_LAUNCH
#define MK_ONE_LAUNCH 1
#endif

#ifndef DUP_MASK
#define DUP_MASK 0
#endif
#define DI __device__ __forceinline__
#define LAS __attribute__((address_space(3)))
typedef unsigned short bf16_t;
typedef short bf16x8 __attribute__((ext_vector_type(8)));
typedef float f32x4 __attribute__((ext_vector_type(4)));
typedef float f32x2 __attribute__((ext_vector_type(2)));
typedef float f32x16 __attribute__((ext_vector_type(16)));
typedef unsigned u32x4 __attribute__((ext_vector_type(4)));
typedef unsigned u32x2 __attribute__((ext_vector_type(2)));
typedef __bf16 bf16x2_t __attribute__((ext_vector_type(2)));

constexpr int DM = 1024, NB = 4, SEQ = 8192, CTX = 256, RB = SEQ + CTX, MT = NB * RB, INW = 7936, FF = 4096, DEPTH = 2;
constexpr int NCH = RB / 64;
constexpr float EPS = 1e-6f;
constexpr float LOG2E = 1.4426950408889634f;
constexpr float QSC = 0.125f * LOG2E;
constexpr int YMW = 1536;
constexpr int C_DQ = 0, C_DK = 512, C_DV = 1024, C_HQ = 1536, C_FF = 2048, C_FB = 2560, C_HI = 3072, C_HG = 3584, C_SQ = 4096, C_SK = 4608, C_SV = 4736, C_GT = 4864;

constexpr size_t MiB = 1u << 20;
constexpr size_t WS_MODS = 0;
constexpr size_t WS_ROPE = 256 * 1024;
constexpr size_t WS_BAR = 512 * 1024;
constexpr size_t WS_CTXR = 4 * MiB;
constexpr size_t WS_W = 8 * MiB;
constexpr size_t WO_IN = 0, WO_BR = 16 * MiB, WO_OUT = 19 * MiB, WO_UP = 21 * MiB, WO_DN = 29 * MiB;
constexpr size_t WS_H = 46 * MiB;
constexpr size_t WS_MG = 112 * MiB;
constexpr size_t WS_BIG = 178 * MiB;
constexpr size_t WB_Y = 0, WB_LOGF = 128 * MiB, WB_VT = 161 * MiB, WB_G = 178 * MiB, WB_ST = 244 * MiB, WB_DEC = 277 * MiB, WB_YM = 278 * MiB;
constexpr size_t WS_END = WS_BIG + 303 * MiB;

constexpr int LDS_BYTES = 147456;
constexpr int NTHR = 512;

DI unsigned pk2(float lo, float hi) { f32x2 v = {lo, hi}; bf16x2_t b = __builtin_convertvector(v, bf16x2_t); return __builtin_bit_cast(unsigned, b); }
DI float bflo(unsigned w) { return __uint_as_float(w << 16); }
DI float bfhi(unsigned w) { return __uint_as_float(w & 0xffff0000u); }
DI float ex2(float x) { return __builtin_amdgcn_exp2f(x); }
DI float fexp(float x) { return ex2(x * LOG2E); }
DI float sigm(float x) { return __builtin_amdgcn_rcpf(1.f + fexp(-x)); }
DI float wave_sum(float v) {
#pragma unroll
    for (int o = 1; o < 64; o <<= 1) v += __shfl_xor(v, o);
    return v;
}
DI int otid() { int t = threadIdx.x; asm volatile("" : "+v"(t)); return t; }
DI int swap23(int i) { return (i & 0x13) | ((i & 4) << 1) | ((i & 8) >> 1); }
#define MFMA32(a, b, c) __builtin_amdgcn_mfma_f32_32x32x16_bf16((a), (b), (c), 0, 0, 0)
DI bf16x8 pack8(const f32x16& x, int s) {
    u32x4 p; p.x = pk2(x[8 * s], x[8 * s + 1]); p.y = pk2(x[8 * s + 2], x[8 * s + 3]); p.z = pk2(x[8 * s + 4], x[8 * s + 5]); p.w = pk2(x[8 * s + 6], x[8 * s + 7]);
    return __builtin_bit_cast(bf16x8, p);
}

namespace pg8 {
constexpr int BM = 256, BK = 64, HALF = 128, HTB = HALF * BK * 2, STAGE_BYTES = 8 * HTB, NXCD = 8, WGM = 8;
DI int lds_byte(int r, int c) { const int st = (r >> 4) * 2 + (c >> 5), rr = r & 15, cc = c & 31, ob = rr * 64 + cc * 2; return st * 1024 + (ob ^ (((ob >> 9) & 1) << 5)); }
DI void stage_rc(int b, int& R, int& C) { const int st = b / 1024, sb = b % 1024, swz = sb ^ (((sb >> 9) & 1) << 5); R = (st >> 1) * 16 + swz / 64; C = (st & 1) * 32 + (swz % 64) / 2; }
DI int perm32(int rho) { const int n = rho >> 4, i = rho & 15; return 8 * (i >> 2) + 4 * n + (i & 3); }
struct Unit { int pm, pn, kind; };
struct GemmDesc { int lda, ldb, K; };
DI void tile_map(int L, int nM, int nN, int& pm, int& pn) {
    const int nwg = nM * nN; int wgid = L;
    { const int q = nwg / NXCD, r = nwg % NXCD, xcd = wgid % NXCD, off = wgid / NXCD; wgid = (xcd < r ? xcd * (q + 1) : r * (q + 1) + (xcd - r) * q) + off; }
    const int nig = WGM * nN, gid = wgid / nig, fm = gid * WGM, gsz = (nM - fm) < WGM ? (nM - fm) : WGM;
    pm = fm + ((wgid % nig) % gsz); pn = (wgid % nig) / gsz;
}

template <class Epi, class Sched>
DI void gemm_phase(LAS unsigned char* lds, const GemmDesc g, const Sched& S, const Epi& E) {
    const int tid = otid(), wid = __builtin_amdgcn_readfirstlane(tid >> 6), lane = tid & 63, wr = wid >> 2, wc = wid & 3, fr = lane & 15, fq = lane >> 4;
    const int K = g.K, nt = K / BK;
    unsigned voffA[2], voffB[2];
#pragma unroll
    for (int i = 0; i < 2; ++i) { int R, C; stage_rc(tid * 16 + i * 8192, R, C); const int Rb = (R & ~31) + perm32(R & 31);
        voffA[i] = (unsigned)(R * g.lda + C) * 2u; voffB[i] = (unsigned)(Rb * g.ldb + C) * 2u; }
    const size_t kstep = (size_t)(BK * 2);
    const size_t hstepA = (size_t)HALF * g.lda * 2, hstepB = (size_t)HALF * g.ldb * 2;
    const unsigned ldsw = (unsigned)wid * 1024u;
    const int aoff = lds_byte(wr * 64 + fr, fq * 8), boff = lds_byte(wc * 32 + fr, fq * 8);
#define PG8_SA(b, h) (((b) * 2 + (h)) * HTB)
#define PG8_SB(b, h) ((4 + (b) * 2 + (h)) * HTB)
#define PG8_STAGE(bufoff, gbase, voff) do { _Pragma("unroll") for (int _i = 0; _i < 2; ++_i) \
        __builtin_amdgcn_global_load_lds((const unsigned*)((const char*)(gbase) + (voff)[_i]), (LAS unsigned*)(lds + (bufoff) + ldsw + _i * 8192), 16, 0, 0); } while (0)
#define PG8_LDA(dst, b, h) do { _Pragma("unroll") for (int m = 0; m < 4; ++m) _Pragma("unroll") for (int k = 0; k < 2; ++k) dst[m][k] = *(const LAS bf16x8*)(lds + PG8_SA(b, h) + aoff + m * 2048 + k * 1024); } while (0)
#define PG8_LDB(dst, b, h) do { _Pragma("unroll") for (int n = 0; n < 2; ++n) _Pragma("unroll") for (int k = 0; k < 2; ++k) dst[n][k] = *(const LAS bf16x8*)(lds + PG8_SB(b, h) + boff + n * 2048 + k * 1024); } while (0)
#define PG8_MMA(ai, bj, At, Bt) do { __builtin_amdgcn_s_setprio(1); _Pragma("unroll") for (int m = 0; m < 4; ++m) _Pragma("unroll") for (int n = 0; n < 2; ++n) _Pragma("unroll") for (int k = 0; k < 2; ++k) \
        acc[ai][bj][m][n] = __builtin_amdgcn_mfma_f32_16x16x32_bf16(Bt[n][k], At[m][k], acc[ai][bj][m][n], 0, 0, 0); __builtin_amdgcn_s_setprio(0); } while (0)
#define PG8_WAIT_V(n) asm volatile("s_waitcnt vmcnt(" #n ")" ::: "memory")
#define PG8_WAIT_L(n) asm volatile("s_waitcnt lgkmcnt(" #n ")" ::: "memory")
#define PG8_BAR __builtin_amdgcn_s_barrier()
#define PG8_SCHED __builtin_amdgcn_sched_barrier(0)
    Unit cur, nxt; int ui = 0;
    if (!S.next(0, cur)) return;
    f32x4 acc[2][2][4][2];
#pragma unroll
    for (int a = 0; a < 2; ++a)
#pragma unroll
        for (int b = 0; b < 2; ++b)
#pragma unroll
            for (int m = 0; m < 4; ++m)
#pragma unroll
                for (int n = 0; n < 2; ++n) acc[a][b][m][n] = (f32x4){0.f, 0.f, 0.f, 0.f};
    bf16x8 At[4][2], B0[2][2], B1[2][2];
    const char* cA = S.a_ptr(cur); const char* cB = S.b_ptr(cur);
    PG8_STAGE(PG8_SB(0, 0), cB, voffB); PG8_STAGE(PG8_SB(0, 1), cB + hstepB, voffB); PG8_STAGE(PG8_SA(0, 0), cA, voffA); PG8_STAGE(PG8_SA(0, 1), cA + hstepA, voffA);
    if (wr == 1) PG8_BAR;
    PG8_WAIT_V(2); PG8_BAR;
    PG8_STAGE(PG8_SB(1, 0), cB + kstep, voffB); PG8_STAGE(PG8_SA(1, 0), cA + kstep, voffA); PG8_STAGE(PG8_SB(1, 1), cB + hstepB + kstep, voffB);
    PG8_WAIT_V(6); PG8_BAR;
    for (;;) {
        const bool has_next = S.next(ui + 1, nxt);
        const char* nA = has_next ? S.a_ptr(nxt) : cA; const char* nB = has_next ? S.b_ptr(nxt) : cB;
        for (int t = 0; t < nt; t += 2) {
            const bool last = (t == nt - 2);
            const char* a1 = cA + (size_t)(t + 1) * kstep;
            const char* a2 = last ? nA : cA + (size_t)(t + 2) * kstep; const char* b2 = last ? nB : cB + (size_t)(t + 2) * kstep;
            const char* a3 = a2 + kstep; const char* b3 = b2 + kstep;
            PG8_LDB(B0, 0, 0); PG8_LDB(B1, 0, 1); PG8_SCHED; PG8_LDA(At, 0, 0); PG8_STAGE(PG8_SA(1, 1), a1 + hstepA, voffA);
            PG8_WAIT_V(8); PG8_WAIT_L(0); PG8_BAR; PG8_MMA(0, 0, At, B0); PG8_MMA(0, 1, At, B1); PG8_BAR; PG8_SCHED;
            PG8_LDA(At, 0, 1); PG8_STAGE(PG8_SB(0, 0), b2, voffB); PG8_STAGE(PG8_SB(0, 1), b2 + hstepB, voffB); PG8_STAGE(PG8_SA(0, 0), a2, voffA);
            PG8_WAIT_V(8); PG8_WAIT_L(0); PG8_BAR; PG8_MMA(1, 0, At, B0); PG8_MMA(1, 1, At, B1); PG8_BAR; PG8_SCHED;
            PG8_LDB(B0, 1, 0); PG8_LDB(B1, 1, 1); PG8_SCHED; PG8_LDA(At, 1, 0); PG8_STAGE(PG8_SA(0, 1), a2 + hstepA, voffA);
            PG8_WAIT_V(8); PG8_WAIT_L(0); PG8_BAR; PG8_MMA(0, 0, At, B0); PG8_MMA(0, 1, At, B1); PG8_BAR; PG8_SCHED;
            PG8_LDA(At, 1, 1); PG8_STAGE(PG8_SB(1, 0), b3, voffB); PG8_STAGE(PG8_SB(1, 1), b3 + hstepB, voffB); PG8_STAGE(PG8_SA(1, 0), a3, voffA);
            PG8_WAIT_V(8); PG8_WAIT_L(0); PG8_BAR; PG8_MMA(1, 0, At, B0); PG8_MMA(1, 1, At, B1); PG8_BAR; PG8_SCHED;
        }
        if (wr == 0) PG8_BAR;
        E(acc, cur, wr, wc, fr, fq);
        if (!has_next) break;
#pragma unroll
        for (int a = 0; a < 2; ++a)
#pragma unroll
            for (int b = 0; b < 2; ++b)
#pragma unroll
                for (int m = 0; m < 4; ++m)
#pragma unroll
                    for (int n = 0; n < 2; ++n) acc[a][b][m][n] = (f32x4){0.f, 0.f, 0.f, 0.f};
        cur = nxt; cA = nA; cB = nB; ++ui;
        if (wr == 1) PG8_BAR;
    }
    PG8_WAIT_V(0);
    PG8_BAR;
#undef PG8_SA
#undef PG8_SB
#undef PG8_STAGE
#undef PG8_LDA
#undef PG8_LDB
#undef PG8_MMA
#undef PG8_WAIT_V
#undef PG8_WAIT_L
#undef PG8_BAR
#undef PG8_SCHED
}
}
using pg8::Unit;

struct SchedWin {
    const char* H; const char* W; int G, c;
    DI bool next(int i, Unit& u) const {
        const int L = i * G + c; if (L >= 1023) return false;
        if (L < 891) { int pm, lp; pg8::tile_map(L, 33, 27, pm, lp); u.pm = pm; u.pn = lp + (lp >= 4 ? 2 : 0) + (lp >= 10 ? 2 : 0); u.kind = 0; }
        else { const int Ls = L - 891; u.pm = Ls / 33; u.pn = Ls % 33; u.kind = 1; }
        return true;
    }
    DI const char* a_ptr(const Unit& u) const { return u.kind == 0 ? H + (size_t)u.pm * 256 * DM * 2 : W + (size_t)((u.pm < 2 ? C_DV : C_HI - 512) + u.pm * 256) * DM * 2; }
    DI const char* b_ptr(const Unit& u) const { return u.kind == 0 ? W + (size_t)u.pn * 256 * DM * 2 : H + (size_t)u.pn * 256 * DM * 2; }
};
struct SchedMerge {
    const char* YM; const char* WB; int c; bool skipctx;
    DI bool next(int i, Unit& u) const { if (i >= 3 || c >= 132 || (skipctx && c < 4)) return false; u.pm = c >> 2; u.pn = c & 3; u.kind = i; return true; }
    DI const char* a_ptr(const Unit& u) const { return YM + ((size_t)u.pm * 256 * YMW + u.kind * 512) * 2; }
    DI const char* b_ptr(const Unit& u) const { return WB + ((size_t)u.kind * DM * 512 + (size_t)u.pn * 256 * 512) * 2; }
};
struct SchedPlain {
    const char* A; const char* Bt; int nM, nN, K, G, c; bool skip;
    DI bool next(int i, Unit& u) const { const int L = i * G + c; if (L >= nM * nN) return false; pg8::tile_map(L, nM, nN, u.pm, u.pn); if (skip) u.pm += u.pm / 32 + 1; u.kind = 0; return true; }
    DI const char* a_ptr(const Unit& u) const { return A + (size_t)u.pm * 256 * K * 2; }
    DI const char* b_ptr(const Unit& u) const { return Bt + (size_t)u.pn * 256 * K * 2; }
};

struct EpiWin {
    bf16_t* Yb; float* LOGF; bf16_t* VT; const float* cosT; const float* sinT; const float* hlb; int layer;
    DI void operator()(const f32x4 (&acc)[2][2][4][2], const Unit& u, int wr, int wc, int fr, int fq) const {
        if (u.kind == 1) {
            const int row0 = u.pm * 256 + wr * 64 + fr, col0 = u.pn * 256 + wc * 32 + 8 * fq;
#pragma unroll
            for (int ai = 0; ai < 2; ++ai)
#pragma unroll
                for (int m = 0; m < 4; ++m) { bf16_t* rowp = VT + (size_t)(row0 + ai * 128 + m * 16) * RB + col0;
#pragma unroll
                    for (int bj = 0; bj < 2; ++bj) { const f32x4 v0 = acc[ai][bj][m][0], v1 = acc[ai][bj][m][1];
                        u32x4 w; w.x = pk2(v0[0], v0[1]); w.y = pk2(v0[2], v0[3]); w.z = pk2(v1[0], v1[1]); w.w = pk2(v1[2], v1[3]);
                        *(u32x4*)(rowp + bj * 128) = w; } }
            return;
        }
        const int pn = u.pn;
        int type; float sc = 1.f;
        if (pn < 2) { type = 0; sc = QSC; } else if (pn < 4) type = 1; else if (pn < 8) type = 2; else if (pn < 12) type = 3; else if (pn < 16) type = 2;
        else if (pn < 18) { type = 0; sc = QSC; } else if (pn == 18) type = 4; else type = 5;
        const bool latent = (u.pm != 0);
        const int cbase = pn * 256 + wc * 32 + 8 * fq;
        float lbv[2][8];
        if (type == 3) {
#pragma unroll
            for (int bj = 0; bj < 2; ++bj)
#pragma unroll
                for (int j = 0; j < 8; ++j) { float lb = 0.f; if (layer == 1) { const int ci = cbase + bj * 128 + j - C_FF; const float a0 = hlb[ci], a1 = hlb[1024 + ci]; lb = __builtin_amdgcn_rcpf(1.f + fexp(a0 - a1)); } lbv[bj][j] = lb; }
        }
        const float sgn = (fq >> 1) ? 1.f : -1.f;
#pragma unroll
        for (int ai = 0; ai < 2; ++ai)
#pragma unroll
            for (int m = 0; m < 4; ++m) {
                const int rl = u.pm * 256 + ai * 128 + wr * 64 + m * 16 + fr;
                float cs[8], sn[8];
                const bool dorope = (type == 0 || type == 1 || type == 4) && latent;
                if (dorope) { const int t = rl - CTX; const int pos = (wc & 1) ? (t & 63) : (t >> 6); const int o = pos * 16 + 8 * (fq & 1);
                    const f32x4 c0 = *(const f32x4*)(cosT + o), c1 = *(const f32x4*)(cosT + o + 4), s0 = *(const f32x4*)(sinT + o), s1 = *(const f32x4*)(sinT + o + 4);
#pragma unroll
                    for (int j = 0; j < 4; ++j) { cs[j] = c0[j]; cs[4 + j] = c1[j]; sn[j] = s0[j]; sn[4 + j] = s1[j]; } }
#pragma unroll
                for (int bj = 0; bj < 2; ++bj) {
                    float v[8];
#pragma unroll
                    for (int j = 0; j < 4; ++j) { v[j] = acc[ai][bj][m][0][j]; v[4 + j] = acc[ai][bj][m][1][j]; }
                    const int col = cbase + bj * 128;
                    if (type == 3) {
                        float o8[8];
#pragma unroll
                        for (int j = 0; j < 8; ++j) { const float kg = (1.f - lbv[bj][j]) * sigm(-v[j]); o8[j] = __logf(1.f - kg); }
#pragma unroll
                        for (int j = 0; j < 8; ++j) v[j] = o8[j];
                    }
                    if (type == 3) { } else if (type == 0 || type == 1 || (type == 4 && bj == 0)) {
                        if (dorope) {
#pragma unroll
                            for (int j = 0; j < 8; ++j) { const float pr = __shfl_xor(v[j], 32); v[j] = v[j] * cs[j] + sgn * pr * sn[j]; }
                        }
#pragma unroll
                        for (int j = 0; j < 8; ++j) v[j] *= sc;
                    } else if (type == 2) {
#pragma unroll
                        for (int j = 0; j < 8; ++j) v[j] = v[j] * sigm(v[j]);
                    } else if (type == 5) {
#pragma unroll
                        for (int j = 0; j < 8; ++j) v[j] = sigm(v[j]);
                    }
                    u32x4 w; w.x = pk2(v[0], v[1]); w.y = pk2(v[2], v[3]); w.z = pk2(v[4], v[5]); w.w = pk2(v[6], v[7]);
                    *(u32x4*)(Yb + (size_t)rl * INW + col) = w;
                }
            }
    }
};
struct EpiMerge {
    const bf16_t* Yb; bf16_t* MS_unused; bf16_t* MG;
    template <int J> DI void body(const f32x4 (&acc)[2][2][4][2], const Unit& u, int wr, int wc, int fr, int fq) const {
        const unsigned cbase = u.pn * 256 + wc * 32 + 8 * fq;
        const unsigned row0 = u.pm * 256 + wr * 64 + fr;
#pragma unroll
        for (int ai = 0; ai < 2; ++ai)
#pragma unroll
            for (int m = 0; m < 4; ++m) { unsigned rl = row0 + ai * 128 + m * 16; asm volatile("" : "+v"(rl));
                const unsigned go = rl * INW + C_GT + J * 1024 + cbase, mo = rl * DM + cbase;
#pragma unroll
                for (int bj = 0; bj < 2; ++bj) {
                    const u32x4 gw = *(const u32x4*)(Yb + go + bj * 128);
                    const f32x4 a0 = acc[ai][bj][m][0], a1 = acc[ai][bj][m][1];
                    f32x4 v0 = {a0[0] * bflo(gw.x), a0[1] * bfhi(gw.x), a0[2] * bflo(gw.y), a0[3] * bfhi(gw.y)};
                    f32x4 v1 = {a1[0] * bflo(gw.z), a1[1] * bfhi(gw.z), a1[2] * bflo(gw.w), a1[3] * bfhi(gw.w)};
                    bf16_t* mg = MG + mo + bj * 128;
                    if (J > 0) { const u32x4 pw = *(const u32x4*)mg; v0 += (f32x4){bflo(pw.x), bfhi(pw.x), bflo(pw.y), bfhi(pw.y)}; v1 += (f32x4){bflo(pw.z), bfhi(pw.z), bflo(pw.w), bfhi(pw.w)}; }
                    u32x4 w; w.x = pk2(v0[0], v0[1]); w.y = pk2(v0[2], v0[3]); w.z = pk2(v1[0], v1[1]); w.w = pk2(v1[2], v1[3]); *(u32x4*)mg = w; }
                asm volatile("" ::: "memory"); }
    }
    DI void operator()(const f32x4 (&acc)[2][2][4][2], const Unit& u, int wr, int wc, int fr, int fq) const {
        if (u.kind == 0) body<0>(acc, u, wr, wc, fr, fq); else if (u.kind == 1) body<1>(acc, u, wr, wc, fr, fq); else body<2>(acc, u, wr, wc, fr, fq);
    }
};
template <int MODE  > struct EpiStore {
    void* O; int ldc;
    DI void operator()(const f32x4 (&acc)[2][2][4][2], const Unit& u, int wr, int wc, int fr, int fq) const {
        const int cbase = u.pn * 256 + wc * 32 + 8 * fq;
#pragma unroll
        for (int ai = 0; ai < 2; ++ai)
#pragma unroll
            for (int m = 0; m < 4; ++m) { const size_t r = (size_t)(u.pm * 256 + ai * 128 + wr * 64 + m * 16 + fr);
#pragma unroll
                for (int bj = 0; bj < 2; ++bj) { const int col = cbase + bj * 128; f32x4 v0 = acc[ai][bj][m][0], v1 = acc[ai][bj][m][1];
                    if (MODE == 0) { float* o = (float*)O + r * ldc + col; *(f32x4*)o = v0; *(f32x4*)(o + 4) = v1; }
                    else { if (MODE == 2) {
#pragma unroll
                            for (int q = 0; q < 4; ++q) { const float a = fmaxf(v0[q], 0.f), b = fmaxf(v1[q], 0.f); v0[q] = a * a; v1[q] = b * b; } }
                        u32x4 w; w.x = pk2(v0[0], v0[1]); w.y = pk2(v0[2], v0[3]); w.z = pk2(v1[0], v1[1]); w.w = pk2(v1[2], v1[3]); *(u32x4*)((bf16_t*)O + r * ldc + col) = w; } } }
    }
};

DI void transpose_item(const float* W, int K, int N, bf16_t* WT, LAS float* scr, int item, int lane) {
    const int nblk = N / 32, kb = item / nblk, nb = item % nblk, k0 = 64 * kb, n0 = 32 * nb;
#pragma unroll 8
    for (int i = 0; i < 32; ++i) { const int kk = 2 * i + (lane >> 5); scr[kk * 33 + (lane & 31)] = W[(size_t)(k0 + kk) * N + n0 + (lane & 31)]; }
    asm volatile("s_waitcnt lgkmcnt(0)" ::: "memory");
    const int c = lane & 7;
#pragma unroll
    for (int j = 0; j < 4; ++j) { const int n = (lane >> 3) + 8 * j; const LAS float* s = scr + (8 * c) * 33 + n;
        u32x4 o; o.x = pk2(s[0 * 33], s[1 * 33]); o.y = pk2(s[2 * 33], s[3 * 33]); o.z = pk2(s[4 * 33], s[5 * 33]); o.w = pk2(s[6 * 33], s[7 * 33]);
        *(u32x4*)(WT + (size_t)(n0 + n) * K + k0 + 8 * c) = o; }
    asm volatile("s_waitcnt lgkmcnt(0)" ::: "memory");
}
struct Ptrs {
    const float *x, *c, *ctx, *c_ctx, *w_ada, *b_ada, *norm_g, *w_in, *diff_lambda, *diff_subln, *hgrn_lb, *hgrn_norm, *swa_sink, *w_branch, *w_out, *w_up, *w_dn;
    float* out; unsigned char* ws;
};
DI void convert_weights(const Ptrs& P, int l, LAS unsigned char* lds, int gw, int ngw, int wave, int lane) {
    LAS float* scr = (LAS float*)(lds + wave * 16384);
    bf16_t* Wb = (bf16_t*)(P.ws + WS_W);
    constexpr int I_IN = 16 * (INW / 32), I_BR = 8 * 32, I_OUT = 16 * 32, I_UP = 16 * 128, I_DN = 64 * 32;
    constexpr int NIT = I_IN + 3 * I_BR + I_OUT + I_UP + I_DN;
    for (int it = gw; it < NIT; it += ngw) {
        int r = it;
        if (r < I_IN) { transpose_item(P.w_in + (size_t)l * DM * INW, DM, INW, Wb + WO_IN / 2, scr, r, lane); continue; } r -= I_IN;
        if (r < 3 * I_BR) { const int j = r / I_BR; transpose_item(P.w_branch + ((size_t)l * 3 + j) * 512 * DM, 512, DM, Wb + WO_BR / 2 + (size_t)j * DM * 512, scr, r % I_BR, lane); continue; } r -= 3 * I_BR;
        if (r < I_OUT) { transpose_item(P.w_out + (size_t)l * DM * DM, DM, DM, Wb + WO_OUT / 2, scr, r, lane); continue; } r -= I_OUT;
        if (r < I_UP) { transpose_item(P.w_up + (size_t)l * DM * FF, DM, FF, Wb + WO_UP / 2, scr, r, lane); continue; } r -= I_UP;
        transpose_item(P.w_dn + (size_t)l * FF * DM, FF, DM, Wb + WO_DN / 2, scr, r, lane);
    }
}
DI void mods_item(const Ptrs& P, int item, LAS unsigned char* lds, int tid, int wave, int lane) {
    LAS float* act = (LAS float*)lds;
    LAS float* red = (LAS float*)(lds + 20480);
    const int l = item / 96, cb = item % 96, n = cb * 64 + lane;
    for (int i = tid; i < 5 * 1024; i += NTHR) { const int v = i >> 10, k = i & 1023; const float cv = v < 4 ? P.c[v * 1024 + k] : P.c_ctx[k]; act[i] = cv * sigm(cv); }
    __syncthreads();
    float a0 = 0.f, a1 = 0.f, a2 = 0.f, a3 = 0.f, a4 = 0.f;
    const float* wp = P.w_ada + (size_t)l * DM * 6144 + n;
#pragma unroll 8
    for (int kk = 0; kk < 128; ++kk) { const int k = wave * 128 + kk; const float w = wp[(size_t)k * 6144];
        a0 += act[k] * w; a1 += act[1024 + k] * w; a2 += act[2048 + k] * w; a3 += act[3072 + k] * w; a4 += act[4096 + k] * w; }
    red[(wave * 5 + 0) * 64 + lane] = a0; red[(wave * 5 + 1) * 64 + lane] = a1; red[(wave * 5 + 2) * 64 + lane] = a2; red[(wave * 5 + 3) * 64 + lane] = a3; red[(wave * 5 + 4) * 64 + lane] = a4;
    __syncthreads();
    if (tid < 320) { const int v = tid >> 6, ln = tid & 63; float s = P.b_ada[l * 6144 + cb * 64 + ln];
#pragma unroll
        for (int w = 0; w < 8; ++w) s += red[(w * 5 + v) * 64 + ln];
        ((float*)(P.ws + WS_MODS))[(l * 5 + v) * 6144 + cb * 64 + ln] = s; }
    __syncthreads();
}
template <int ADD  >
DI void row_update(const float* res_in, float* res_out, const void* add_row, const float* gate, const float* gain_add,
                   const float* gain_h, const float* shift, const float* scale, bf16_t* hrow, int lane) {
    f32x4 v[4];
#pragma unroll
    for (int j = 0; j < 4; ++j) v[j] = *(const f32x4*)(res_in + 4 * lane + 256 * j);
    if (ADD != 0) {
        f32x4 y[4]; float ss = 0.f;
#pragma unroll
        for (int j = 0; j < 4; ++j) {
            if (ADD == 1) y[j] = *(const f32x4*)((const float*)add_row + 4 * lane + 256 * j);
            else { const u32x2 w = *(const u32x2*)((const bf16_t*)add_row + 4 * lane + 256 * j); y[j] = (f32x4){bflo(w.x), bfhi(w.x), bflo(w.y), bfhi(w.y)}; }
            ss += (y[j][0] * y[j][0] + y[j][1] * y[j][1]) + (y[j][2] * y[j][2] + y[j][3] * y[j][3]); }
        const float rstd = __builtin_amdgcn_rsqf(wave_sum(ss) * (1.f / DM) + EPS);
#pragma unroll
        for (int j = 0; j < 4; ++j) { const f32x4 gt = *(const f32x4*)(gate + 4 * lane + 256 * j), ga = *(const f32x4*)(gain_add + 4 * lane + 256 * j);
            v[j] += gt * (y[j] * rstd * ga); }
    }
    if (res_out) {
#pragma unroll
        for (int j = 0; j < 4; ++j) *(f32x4*)(res_out + 4 * lane + 256 * j) = v[j];
    }
    if (hrow) {
        float ss = 0.f;
#pragma unroll
        for (int j = 0; j < 4; ++j) ss += (v[j][0] * v[j][0] + v[j][1] * v[j][1]) + (v[j][2] * v[j][2] + v[j][3] * v[j][3]);
        const float rstd = __builtin_amdgcn_rsqf(wave_sum(ss) * (1.f / DM) + EPS);
#pragma unroll
        for (int j = 0; j < 4; ++j) { const f32x4 gh = *(const f32x4*)(gain_h + 4 * lane + 256 * j), sh = *(const f32x4*)(shift + 4 * lane + 256 * j), scl = *(const f32x4*)(scale + 4 * lane + 256 * j);
            const f32x4 h = (v[j] * rstd * gh) * (scl + 1.f) + sh;
            u32x2 w; w.x = pk2(h[0], h[1]); w.y = pk2(h[2], h[3]); *(u32x2*)(hrow + 4 * lane + 256 * j) = w; }
    }
}

DI void diff_attn_unit(LAS unsigned char* lds, const bf16_t* Yb, const bf16_t* VTb, bf16_t* YMb, int h, int q0, int nkeys, float lam, const float* subln, float oscale, const unsigned* kmaxp) {
    const int tid = otid(), lane = tid & 63, wid = __builtin_amdgcn_readfirstlane(tid >> 6), r32 = lane & 31, hi = lane >> 5;
    const int c = wid & 1, sub = wid >> 1;
    constexpr int KROW = 272, KBUF = 64 * KROW, VROW = 144, VBUF = 128 * VROW, VOFF = 2 * KBUF;
    const bf16_t* kg = Yb + C_DK + h * 128;
    const bf16_t* vg = VTb + (size_t)(h * 128) * RB;
    const int kr0 = tid >> 4, kc0 = tid & 15, vr0 = tid >> 3, vc0 = tid & 7;
    bf16x8 qf[4];
    { const bf16_t* qp = Yb + (size_t)(q0 + 32 * sub + r32) * INW + C_DQ + h * 128 + c * 64 + hi * 8;
#pragma unroll
      for (int d0 = 0; d0 < 4; ++d0) qf[d0] = *(const bf16x8*)(qp + 16 * d0); }
    bf16x8 qf4, kone, ones;
    { float ss = 0.f;
#pragma unroll
      for (int d0 = 0; d0 < 4; ++d0)
#pragma unroll
          for (int j = 0; j < 8; ++j) { const float v = __uint_as_float(((unsigned)(unsigned short)qf[d0][j]) << 16); ss += v * v; }
      ss += __shfl_xor(ss, 32);
      const float mub = sqrtf(ss) * __uint_as_float(kmaxp[h * 2 + c]) * 1.01f;
      const short e = hi == 0 ? (short)(pk2(-mub, 0.f) & 0xffffu) : (short)0, o1 = hi == 0 ? (short)0x3F80 : (short)0;
      qf4 = (bf16x8){e, 0, 0, 0, 0, 0, 0, 0}; kone = (bf16x8){o1, 0, 0, 0, 0, 0, 0, 0};
      ones = (bf16x8){(short)0x3F80, (short)0x3F80, (short)0x3F80, (short)0x3F80, (short)0x3F80, (short)0x3F80, (short)0x3F80, (short)0x3F80}; }
    f32x16 O[4], L;
#pragma unroll
    for (int r = 0; r < 16; ++r) { O[0][r] = 0.f; O[1][r] = 0.f; O[2][r] = 0.f; O[3][r] = 0.f; L[r] = 0.f; }
    const int NT = nkeys / 64;
    u32x4 kr[1][2], vr[1][2];
    f32x16 P0, P1;
#define DA_LOADK(S, t) do { kr[S][0] = *(const u32x4*)(kg + (size_t)((t) * 64 + kr0) * INW + kc0 * 8); kr[S][1] = *(const u32x4*)(kg + (size_t)((t) * 64 + kr0 + 32) * INW + kc0 * 8); } while (0)
#define DA_LOADV(S, t) do { vr[S][0] = *(const u32x4*)(vg + (size_t)vr0 * RB + (t) * 64 + vc0 * 8); vr[S][1] = *(const u32x4*)(vg + (size_t)(vr0 + 64) * RB + (t) * 64 + vc0 * 8); } while (0)
#define DA_STOREK(S, b) do { *(LAS u32x4*)(lds + (b) * KBUF + kr0 * KROW + kc0 * 16) = kr[S][0]; *(LAS u32x4*)(lds + (b) * KBUF + (kr0 + 32) * KROW + kc0 * 16) = kr[S][1]; } while (0)
#define DA_STOREV(S, b) do { *(LAS u32x4*)(lds + VOFF + (b) * VBUF + vr0 * VROW + vc0 * 16) = vr[S][0]; *(LAS u32x4*)(lds + VOFF + (b) * VBUF + (vr0 + 64) * VROW + vc0 * 16) = vr[S][1]; } while (0)
    const int kro = swap23(r32) * KROW + (c * 64 + 8 * hi) * 2;
    const int vro = VOFF + r32 * VROW + hi * 16;
    DA_LOADK(0, 0); DA_STOREK(0, 0);
    __syncthreads();
    {
        DA_LOADK(0, 1); DA_LOADV(0, 0);
        asm volatile("" ::: "memory");
        const LAS unsigned char* kb = lds + kro;
#pragma unroll
        for (int r = 0; r < 16; ++r) { P0[r] = 0.f; P1[r] = 0.f; }
        P0 = MFMA32(kone, qf4, P0); P1 = MFMA32(kone, qf4, P1);
#pragma unroll
        for (int d0 = 0; d0 < 4; ++d0) { const bf16x8 a0 = *(const LAS bf16x8*)(kb + d0 * 32), a1 = *(const LAS bf16x8*)(kb + 32 * KROW + d0 * 32);
            P0 = MFMA32(a0, qf[d0], P0); P1 = MFMA32(a1, qf[d0], P1); }
#pragma unroll
        for (int r = 0; r < 16; ++r) { P0[r] = ex2(P0[r]); P1[r] = ex2(P1[r]); }
        DA_STOREK(0, 1); DA_STOREV(0, 0);
        __syncthreads();
    }
#define DA_ITER(t, LS, SS) do { \
        const int b = (t) & 1; \
        if ((t) + 1 < NT) DA_LOADK(0, (t) + 1); \
        DA_LOADV(0, (t)); \
        asm volatile("" ::: "memory"); \
        const LAS unsigned char* kb = lds + b * KBUF + kro; \
        const LAS unsigned char* vb = lds + (b ^ 1) * VBUF + vro; \
        f32x16 s0, s1; \
        _Pragma("unroll") for (int r = 0; r < 16; ++r) { s0[r] = 0.f; s1[r] = 0.f; } \
        s0 = MFMA32(kone, qf4, s0); s1 = MFMA32(kone, qf4, s1); \
        _Pragma("unroll") for (int d0 = 0; d0 < 4; ++d0) { const bf16x8 a0 = *(const LAS bf16x8*)(kb + d0 * 32), a1 = *(const LAS bf16x8*)(kb + 32 * KROW + d0 * 32); \
            s0 = MFMA32(a0, qf[d0], s0); s1 = MFMA32(a1, qf[d0], s1); } \
        bf16x8 pf[4]; pf[0] = pack8(P0, 0); pf[1] = pack8(P0, 1); pf[2] = pack8(P1, 0); pf[3] = pack8(P1, 1); \
        _Pragma("unroll") for (int sp = 0; sp < 4; ++sp) { \
            _Pragma("unroll") for (int dvb = 0; dvb < 4; ++dvb) { const bf16x8 a = *(const LAS bf16x8*)(vb + dvb * 32 * VROW + sp * 32); O[dvb] = MFMA32(a, pf[sp], O[dvb]); } \
            L = MFMA32(ones, pf[sp], L); } \
        _Pragma("unroll") for (int r = 0; r < 16; ++r) { P0[r] = ex2(s0[r]); P1[r] = ex2(s1[r]); } \
        asm volatile("" : "+v"(P0), "+v"(P1)); \
        __builtin_amdgcn_sched_group_barrier(0x100, 4, 0); \
        __builtin_amdgcn_sched_group_barrier(0x008, 2, 0); \
        _Pragma("unroll") for (int i = 0; i < 8; ++i) { __builtin_amdgcn_sched_group_barrier(0x008, 1, 0); __builtin_amdgcn_sched_group_barrier(0x100, 1, 0); __builtin_amdgcn_sched_group_barrier(0x002, 2, 0); } \
        _Pragma("unroll") for (int i = 0; i < 12; ++i) { __builtin_amdgcn_sched_group_barrier(0x008, 1, 0); __builtin_amdgcn_sched_group_barrier(0x100, 1, 0); __builtin_amdgcn_sched_group_barrier(0x002, 2, 0); } \
        _Pragma("unroll") for (int i = 0; i < 8; ++i) { __builtin_amdgcn_sched_group_barrier(0x008, 1, 0); __builtin_amdgcn_sched_group_barrier(0x002, 1, 0); } \
        __builtin_amdgcn_sched_barrier(0); \
        if ((t) + 1 < NT) DA_STOREK(0, b ^ 1); \
        DA_STOREV(0, b); \
        __syncthreads(); \
    } while (0)
    if (wid >= 4) __builtin_amdgcn_s_setprio(1);
#pragma clang loop unroll(disable)
    for (int t = 1; t < NT; ++t) { DA_ITER(t, 0, 0); }
    __builtin_amdgcn_s_setprio(0);
#undef DA_ITER
    {
        const LAS unsigned char* vb = lds + ((NT - 1) & 1) * VBUF + vro;
        bf16x8 pf[4]; pf[0] = pack8(P0, 0); pf[1] = pack8(P0, 1); pf[2] = pack8(P1, 0); pf[3] = pack8(P1, 1);
#pragma unroll
        for (int sp = 0; sp < 4; ++sp) {
#pragma unroll
            for (int dvb = 0; dvb < 4; ++dvb) { const bf16x8 a = *(const LAS bf16x8*)(vb + dvb * 32 * VROW + sp * 32); O[dvb] = MFMA32(a, pf[sp], O[dvb]); }
            L = MFMA32(ones, pf[sp], L); }
    }
#undef DA_LOADK
#undef DA_LOADV
#undef DA_STOREK
#undef DA_STOREV
    __syncthreads();
    const float inv = __builtin_amdgcn_rcpf(L[0]);
    LAS float* ex = (LAS float*)lds;
    LAS float* sl = (LAS float*)(lds + 65536);
    if (tid < 128) sl[tid] = subln[tid];
    if (c == 1) {
#pragma unroll
        for (int dvb = 0; dvb < 4; ++dvb)
#pragma unroll
            for (int r = 0; r < 16; ++r) ex[((sub * 4 + dvb) * 16 + r) * 64 + lane] = O[dvb][r] * inv;
    }
    __syncthreads();
    if (c == 0) {
        float ss = 0.f;
#pragma unroll
        for (int dvb = 0; dvb < 4; ++dvb)
#pragma unroll
            for (int r = 0; r < 16; ++r) { const float o = O[dvb][r] * inv - lam * ex[((sub * 4 + dvb) * 16 + r) * 64 + lane]; O[dvb][r] = o; ss += o * o; }
        ss += __shfl_xor(ss, 32);
        const float rstd = __builtin_amdgcn_rsqf(ss * (1.f / 128.f) + EPS) * oscale;
        bf16_t* orow = YMb + (size_t)(q0 + 32 * sub + r32) * YMW + h * 128;
#pragma unroll
        for (int dvb = 0; dvb < 4; ++dvb)
#pragma unroll
            for (int rp = 0; rp < 2; ++rp) {
                u32x2 w[2];
#pragma unroll
                for (int q = 0; q < 2; ++q) { const int rg = 2 * rp + q; const int dv0 = 32 * dvb + 8 * rg + 4 * hi; const f32x4 g = *(const LAS f32x4*)(sl + dv0);
                    w[q].x = pk2(O[dvb][4 * rg] * rstd * g[0], O[dvb][4 * rg + 1] * rstd * g[1]); w[q].y = pk2(O[dvb][4 * rg + 2] * rstd * g[2], O[dvb][4 * rg + 3] * rstd * g[3]); }
                { auto r0 = __builtin_amdgcn_permlane32_swap(w[0].x, w[1].x, false, false); w[0].x = r0[0]; w[1].x = r0[1];
                  auto r1 = __builtin_amdgcn_permlane32_swap(w[0].y, w[1].y, false, false); w[0].y = r1[0]; w[1].y = r1[1]; }
                u32x4 o; o.x = w[0].x; o.y = w[0].y; o.z = w[1].x; o.w = w[1].y;
                *(u32x4*)(orow + 32 * dvb + 16 * rp + 8 * hi) = o; }
    }
    __syncthreads();
}
DI void kmax_item(LAS unsigned char* lds, const bf16_t* Yb, unsigned* kmaxp, int item) {
    const int tid = otid(), lane = tid & 63, wid = tid >> 6;
    const int hm = item / 33, rt = item % 33;
    const bf16_t* kp = Yb + (size_t)(rt * 256 + (tid >> 1)) * INW + (hm < 8 ? C_DK + hm * 64 : C_SK + (hm - 8) * 64) + (tid & 1) * 32;
    float ss = 0.f;
#pragma unroll
    for (int i = 0; i < 4; ++i) { const u32x4 w = *(const u32x4*)(kp + 8 * i);
        const float a0 = bflo(w.x), a1 = bfhi(w.x), a2 = bflo(w.y), a3 = bfhi(w.y), a4 = bflo(w.z), a5 = bfhi(w.z), a6 = bflo(w.w), a7 = bfhi(w.w);
        ss += (a0 * a0 + a1 * a1) + (a2 * a2 + a3 * a3) + (a4 * a4 + a5 * a5) + (a6 * a6 + a7 * a7); }
    ss += __shfl_xor(ss, 1);
#pragma unroll
    for (int o = 2; o < 64; o <<= 1) ss = fmaxf(ss, __shfl_xor(ss, o));
    LAS float* red = (LAS float*)lds;
    __syncthreads();
    if (lane == 0) red[wid] = ss;
    __syncthreads();
    if (tid == 0) { float mx = red[0];
#pragma unroll
        for (int w = 1; w < 8; ++w) mx = fmaxf(mx, red[w]);
        atomicMax(kmaxp + hm, __float_as_uint(sqrtf(mx))); }
}

DI void swa_unit(LAS unsigned char* lds, const bf16_t* Yb, bf16_t* YMb, int kvh, int qb, bool latent, const float* sink, const unsigned* kmaxp) {
    const int tid = otid(), lane = tid & 63, wid = __builtin_amdgcn_readfirstlane(tid >> 6), r32 = lane & 31, hi = lane >> 5;
    const int sub = wid & 1, hq = kvh * 4 + (wid >> 1);
    constexpr int ROW = 144, VOFF = 64 * ROW, BUF = 2 * 64 * ROW;
    const int q0 = latent ? CTX + 64 * qb : 64 * qb;
    const int srow = tid >> 3, spc = tid & 7;
    const int qpos = 64 * qb + 32 * sub + r32;
    const int wlo = 4 + (qb < 2 ? 2 - qb : 0), whi = latent ? 4 + (129 - qb < 4 ? 129 - qb : 4) : 3;
    bf16x8 qf[4];
    { const bf16_t* qp = Yb + (size_t)(q0 + 32 * sub + r32) * INW + C_SQ + hq * 64 + hi * 8;
#pragma unroll
      for (int d0 = 0; d0 < 4; ++d0) qf[d0] = *(const bf16x8*)(qp + 16 * d0); }
    float mub, l;
    { float ss = 0.f;
#pragma unroll
      for (int d0 = 0; d0 < 4; ++d0)
#pragma unroll
          for (int j = 0; j < 8; ++j) { const float v = __uint_as_float(((unsigned)(unsigned short)qf[d0][j]) << 16); ss += v * v; }
      ss += __shfl_xor(ss, 32);
      const float sk = sink[hq] * LOG2E;
      mub = fmaxf(sqrtf(ss) * __uint_as_float(kmaxp[8 + kvh]) * 1.01f, sk);
      l = hi == 0 ? ex2(sk - mub) : 0.f; }
    f32x16 O[2];
#pragma unroll
    for (int i = 0; i < 2; ++i)
#pragma unroll
        for (int r = 0; r < 16; ++r) O[i][r] = 0.f;
    u32x4 kv, vv;
#define SWA_LOAD(it_) do { const int kr_ = (it_) < 4 ? 64 * (it_) : CTX + 64 * qb - 128 + 64 * ((it_) - 4); \
        kv = *(const u32x4*)(Yb + (size_t)(kr_ + srow) * INW + C_SK + kvh * 64 + spc * 8); vv = *(const u32x4*)(Yb + (size_t)(kr_ + lane) * INW + C_SV + kvh * 64 + wid * 8); } while (0)
#define SWA_STORE(p_) do { *(LAS u32x4*)(lds + (p_) * BUF + srow * ROW + spc * 16) = kv; \
        LAS bf16_t* vt = (LAS bf16_t*)(lds + (p_) * BUF + VOFF) + wid * 8 * (ROW / 2) + lane; \
        vt[0 * (ROW / 2)] = (bf16_t)(vv.x & 0xffff); vt[1 * (ROW / 2)] = (bf16_t)(vv.x >> 16); vt[2 * (ROW / 2)] = (bf16_t)(vv.y & 0xffff); vt[3 * (ROW / 2)] = (bf16_t)(vv.y >> 16); \
        vt[4 * (ROW / 2)] = (bf16_t)(vv.z & 0xffff); vt[5 * (ROW / 2)] = (bf16_t)(vv.z >> 16); vt[6 * (ROW / 2)] = (bf16_t)(vv.w & 0xffff); vt[7 * (ROW / 2)] = (bf16_t)(vv.w >> 16); } while (0)
    SWA_LOAD(0); SWA_STORE(0);
    __syncthreads();
    int p = 0;
#pragma clang loop unroll(disable)
    for (int it = 0; it <= whi; it = (it == 3 ? wlo : it + 1)) {
        const int kp = 64 * qb - 128 + 64 * (it - 4);
        const int nx = it == 3 ? wlo : it + 1;
        if (nx <= whi) SWA_LOAD(nx);
        asm volatile("" ::: "memory");
        const LAS unsigned char* kb = lds + p * BUF + swap23(r32) * ROW + hi * 16;
        const LAS unsigned char* vb = lds + p * BUF + VOFF + r32 * ROW + hi * 16;
        f32x16 s0, s1;
#pragma unroll
        for (int r = 0; r < 16; ++r) { s0[r] = -mub; s1[r] = -mub; }
#pragma unroll
        for (int d0 = 0; d0 < 4; ++d0) { const bf16x8 k0 = *(const LAS bf16x8*)(kb + d0 * 32), k1 = *(const LAS bf16x8*)(kb + 32 * ROW + d0 * 32); s0 = MFMA32(k0, qf[d0], s0); s1 = MFMA32(k1, qf[d0], s1); }
        if (it >= 4) {
            const int dbase = kp + 8 * hi - qpos;
#pragma unroll
            for (int r = 0; r < 16; ++r) { const int d0 = dbase + (r & 3) + 4 * ((r >> 2) & 1) + 16 * ((r >> 3) & 1), d1 = d0 + 32;
                if (d0 > 128 || d0 < -128) s0[r] = -INFINITY; if (d1 > 128 || d1 < -128) s1[r] = -INFINITY; }
        }
        float ps = 0.f;
#pragma unroll
        for (int r = 0; r < 16; ++r) { s0[r] = ex2(s0[r]); s1[r] = ex2(s1[r]); ps += s0[r] + s1[r]; }
        l += ps;
        bf16x8 pf[4]; pf[0] = pack8(s0, 0); pf[1] = pack8(s0, 1); pf[2] = pack8(s1, 0); pf[3] = pack8(s1, 1);
#pragma unroll
        for (int dvb = 0; dvb < 2; ++dvb)
#pragma unroll
            for (int sp = 0; sp < 4; ++sp) { const bf16x8 a = *(const LAS bf16x8*)(vb + dvb * 32 * ROW + sp * 32); O[dvb] = MFMA32(a, pf[sp], O[dvb]); }
        if (nx <= whi) SWA_STORE(p ^ 1);
        __syncthreads();
        p ^= 1;
    }
#undef SWA_LOAD
#undef SWA_STORE
    const float lt = l + __shfl_xor(l, 32);
    const float inv = __builtin_amdgcn_rcpf(lt);
    bf16_t* orow = YMb + (size_t)(q0 + 32 * sub + r32) * YMW + 1024 + hq * 64;
#pragma unroll
    for (int dvb = 0; dvb < 2; ++dvb)
#pragma unroll
        for (int rg = 0; rg < 4; ++rg) { const int dv0 = 32 * dvb + 8 * rg + 4 * hi;
            u32x2 w; w.x = pk2(O[dvb][4 * rg] * inv, O[dvb][4 * rg + 1] * inv); w.y = pk2(O[dvb][4 * rg + 2] * inv, O[dvb][4 * rg + 3] * inv);
            *(u32x2*)(orow + dv0) = w; }
}

DI int hgrn_chunk(int mb, int dir) { return dir == 0 ? mb : (mb < 4 ? 3 - mb : 135 - mb); }
DI void hgrn_pass1_unit(LAS unsigned char* lds, const bf16_t* LOGF  , const bf16_t* VTb, bf16_t* G, float* DEC, int h, int mb) {
    const int tid = otid(), lane = tid & 63, wid = __builtin_amdgcn_readfirstlane(tid >> 6), r32 = lane & 31, hi = lane >> 5;
    LAS float* LB = (LAS float*)lds;
    constexpr int VTO = 65536, VROW = 144, KTO = VTO + 128 * VROW, KTB = 128 * VROW;
#pragma unroll
    for (int i = 0; i < 4; ++i) { const int idx = tid + NTHR * i, dir = idx >> 10, rem = idx & 1023, s = rem >> 4, k8 = rem & 15;
        const u32x4 w = *(const u32x4*)(LOGF + (size_t)(64 * mb + s) * INW + C_FF + dir * 512 + h * 128 + 8 * k8);
        LAS float* dst = LB + (dir * 64 + s) * 128 + 8 * k8;
        *(LAS f32x4*)dst = (f32x4){bflo(w.x), bfhi(w.x), bflo(w.y), bfhi(w.y)}; *(LAS f32x4*)(dst + 4) = (f32x4){bflo(w.z), bfhi(w.z), bflo(w.w), bfhi(w.w)}; }
#pragma unroll
    for (int i = 0; i < 2; ++i) { const int pc = tid + NTHR * i, v = pc >> 3, c8 = pc & 7;
        *(LAS u32x4*)(lds + VTO + v * VROW + c8 * 16) = *(const u32x4*)(VTb + (size_t)(512 + h * 128 + v) * RB + 64 * mb + 8 * c8); }
    __syncthreads();
    if (tid < 256) { const int dir = tid >> 7, k = tid & 127; float a = 0.f;
        LAS float* lb = LB + dir * 64 * 128 + k; float v[64];
#pragma unroll
        for (int s = 0; s < 64; ++s) v[s] = lb[s * 128];
        if (dir == 0) {
#pragma unroll
            for (int s = 0; s < 64; ++s) { a += v[s]; v[s] = a; } }
        else {
#pragma unroll
            for (int s = 63; s >= 0; --s) { a += v[s]; v[s] = a; } }
#pragma unroll
        for (int s = 0; s < 64; ++s) lb[s * 128] = v[s];
        DEC[((size_t)(h * 2 + dir) * NCH + hgrn_chunk(mb, dir)) * 128 + k] = fexp(a); }
    __syncthreads();
    { const int dir = tid >> 8, k = tid & 127, sh = (tid >> 7) & 1;
      const LAS float* lb = LB + dir * 64 * 128 + k;
      const float bl = dir == 0 ? lb[63 * 128] : lb[0];
      LAS unsigned* kt = (LAS unsigned*)(lds + KTO + dir * KTB + k * VROW);
#pragma unroll 4
      for (int sp = 0; sp < 16; ++sp) { const int s = 32 * sh + 2 * sp;
          const float b0 = lb[s * 128], b1 = lb[(s + 1) * 128];
          float lf0, lf1;
          if (dir == 0) { lf0 = s == 0 ? b0 : b0 - lb[(s - 1) * 128]; lf1 = b1 - b0; }
          else { lf1 = s + 1 == 63 ? b1 : b1 - lb[(s + 2) * 128]; lf0 = b0 - b1; }
          const float k0 = (1.f - fexp(lf0)) * fexp(bl - b0), k1 = (1.f - fexp(lf1)) * fexp(bl - b1);
          kt[s >> 1] = pk2(k0, k1); } }
    __syncthreads();
    { const int dir = wid >> 2, vb = wid & 3;
      f32x16 acc[4];
#pragma unroll
      for (int i = 0; i < 4; ++i)
#pragma unroll
          for (int r = 0; r < 16; ++r) acc[i][r] = 0.f;
      const LAS unsigned char* va = lds + VTO + (32 * vb + r32) * VROW + hi * 16;
      const LAS unsigned char* ka = lds + KTO + dir * KTB + r32 * VROW + hi * 16;
#pragma unroll
      for (int st = 0; st < 4; ++st) { const bf16x8 a = *(const LAS bf16x8*)(va + st * 32);
#pragma unroll
          for (int kb = 0; kb < 4; ++kb) { const bf16x8 b = *(const LAS bf16x8*)(ka + kb * 32 * VROW + st * 32); acc[kb] = MFMA32(a, b, acc[kb]); } }
      bf16_t* g = G + ((size_t)(h * 2 + dir) * NCH + hgrn_chunk(mb, dir)) * 16384;
#pragma unroll
      for (int kb = 0; kb < 4; ++kb)
#pragma unroll
          for (int r = 0; r < 16; ++r) { const int v = 32 * vb + (r & 3) + 8 * (r >> 2) + 4 * hi; g[v * 128 + 32 * kb + r32] = (bf16_t)(pk2(acc[kb][r], 0.f) & 0xffffu); } }
    __syncthreads();
}
DI void hgrn_pass2(const bf16_t* G, const float* DEC, bf16_t* ST, int e0, int e1, int tid) {
    for (int e = e0 + 2 * tid; e < e1; e += 2 * NTHR) {
        const int ch = e >> 14, vk = e & 16383, k = vk & 127;
        const bf16_t* g = G + (size_t)ch * NCH * 16384 + vk; const float* d = DEC + (size_t)ch * NCH * 128 + k; bf16_t* st = ST + (size_t)ch * NCH * 16384 + vk;
        float S0 = 0.f, S1 = 0.f;
        for (int n0 = 0; n0 < NCH; n0 += 33) {
            unsigned gv[33]; f32x2 dv[33];
#pragma unroll
            for (int j = 0; j < 33; ++j) { gv[j] = *(const unsigned*)(g + (size_t)(n0 + j) * 16384); dv[j] = *(const f32x2*)(d + (n0 + j) * 128); }
#pragma unroll
            for (int j = 0; j < 33; ++j) { *(unsigned*)(st + (size_t)(n0 + j) * 16384) = pk2(S0, S1); S0 = dv[j][0] * S0 + bflo(gv[j]); S1 = dv[j][1] * S1 + bfhi(gv[j]); }
        }
    }
}
DI void hgrn_pass3_unit(LAS unsigned char* lds, const bf16_t* Yb, const float* LOGF, const bf16_t* VTb, const bf16_t* ST, bf16_t* YMb, const float* hnorm, int h, int mb) {
    const int tid = otid(), lane = tid & 63, wid = __builtin_amdgcn_readfirstlane(tid >> 6), r32 = lane & 31, hi = lane >> 5;
    LAS float* LB = (LAS float*)lds;
    constexpr int PR = 272, QHO = 32768, KHO = QHO + 64 * PR, STO = KHO + 64 * PR, VTO = STO + 128 * PR, VROW = 144, ATO = VTO + 128 * VROW, SSO = ATO + 64 * VROW;
    const int tb = wid & 1, vb = wid >> 1;
    f32x16 acc;
#pragma unroll
    for (int r = 0; r < 16; ++r) acc[r] = 0.f;
#pragma unroll
    for (int i = 0; i < 2; ++i) { const int pc = tid + NTHR * i, v = pc >> 3, c8 = pc & 7;
        *(LAS u32x4*)(lds + VTO + v * VROW + c8 * 16) = *(const u32x4*)(VTb + (size_t)(512 + h * 128 + v) * RB + 64 * mb + 8 * c8); }
#pragma unroll 1
    for (int dir = 0; dir < 2; ++dir) {
        u32x4 lg[2]; u32x4 qq0, qq1, stv[4];
#pragma unroll
        for (int i = 0; i < 2; ++i) { const int idx = tid + NTHR * i, s = idx >> 4, k8 = idx & 15;
            lg[i] = *(const u32x4*)(Yb + (size_t)(64 * mb + s) * INW + C_FF + dir * 512 + h * 128 + 8 * k8); }
        { const bf16_t* qp = Yb + (size_t)(64 * mb + (tid >> 3)) * INW + C_HQ + h * 128 + 16 * (tid & 7); qq0 = *(const u32x4*)qp; qq1 = *(const u32x4*)(qp + 8); }
        { const bf16_t* st = ST + ((size_t)(h * 2 + dir) * NCH + hgrn_chunk(mb, dir)) * 16384;
#pragma unroll
          for (int i = 0; i < 4; ++i) { const int pc = tid + NTHR * i; stv[i] = *(const u32x4*)(st + (pc >> 4) * 128 + (pc & 15) * 8); } }
        asm volatile("" ::: "memory");
        __syncthreads();
#pragma unroll
        for (int i = 0; i < 2; ++i) { const int idx = tid + NTHR * i, s = idx >> 4, k8 = idx & 15; const u32x4 w = lg[i];
            LAS float* dst = LB + s * 128 + 8 * k8;
            *(LAS f32x4*)dst = (f32x4){bflo(w.x), bfhi(w.x), bflo(w.y), bfhi(w.y)}; *(LAS f32x4*)(dst + 4) = (f32x4){bflo(w.z), bfhi(w.z), bflo(w.w), bfhi(w.w)}; }
        __syncthreads();
        if (tid < 128) { float a = 0.f; LAS float* lb = LB + tid; float v[64];
#pragma unroll
            for (int s = 0; s < 64; ++s) v[s] = lb[s * 128];
            if (dir == 0) {
#pragma unroll
                for (int s = 0; s < 64; ++s) { a += v[s]; v[s] = a; } }
            else {
#pragma unroll
                for (int s = 63; s >= 0; --s) { a += v[s]; v[s] = a; } }
#pragma unroll
            for (int s = 0; s < 64; ++s) lb[s * 128] = v[s]; }
        __syncthreads();
        const int mid = dir == 0 ? 31 : 32;
        { const int s = tid >> 3, kc = tid & 7;
          const u32x4 q0 = qq0, q1 = qq1;
          float qv[16] = {bflo(q0.x), bfhi(q0.x), bflo(q0.y), bfhi(q0.y), bflo(q0.z), bfhi(q0.z), bflo(q0.w), bfhi(q0.w), bflo(q1.x), bfhi(q1.x), bflo(q1.y), bfhi(q1.y), bflo(q1.z), bfhi(q1.z), bflo(q1.w), bfhi(q1.w)};
          float qh[16], kh[16];
          const int sn = dir == 0 ? s - 1 : s + 1; const bool edge = dir == 0 ? (s == 0) : (s == 63);
#pragma unroll
          for (int j4 = 0; j4 < 4; ++j4) { const f32x4 b = *(const LAS f32x4*)(LB + s * 128 + 16 * kc + 4 * j4), rr = *(const LAS f32x4*)(LB + mid * 128 + 16 * kc + 4 * j4);
              f32x4 bn = {0.f, 0.f, 0.f, 0.f}; if (!edge) bn = *(const LAS f32x4*)(LB + sn * 128 + 16 * kc + 4 * j4);
#pragma unroll
              for (int j = 0; j < 4; ++j) { const float lf = b[j] - bn[j]; qh[4 * j4 + j] = qv[4 * j4 + j] * fexp(fminf(b[j] - rr[j], 80.f)); kh[4 * j4 + j] = (1.f - fexp(lf)) * fexp(fminf(rr[j] - b[j], 80.f)); } }
          u32x4 w0, w1;
          w0.x = pk2(qh[0], qh[1]); w0.y = pk2(qh[2], qh[3]); w0.z = pk2(qh[4], qh[5]); w0.w = pk2(qh[6], qh[7]); w1.x = pk2(qh[8], qh[9]); w1.y = pk2(qh[10], qh[11]); w1.z = pk2(qh[12], qh[13]); w1.w = pk2(qh[14], qh[15]);
          *(LAS u32x4*)(lds + QHO + s * PR + kc * 32) = w0; *(LAS u32x4*)(lds + QHO + s * PR + kc * 32 + 16) = w1;
          w0.x = pk2(kh[0], kh[1]); w0.y = pk2(kh[2], kh[3]); w0.z = pk2(kh[4], kh[5]); w0.w = pk2(kh[6], kh[7]); w1.x = pk2(kh[8], kh[9]); w1.y = pk2(kh[10], kh[11]); w1.z = pk2(kh[12], kh[13]); w1.w = pk2(kh[14], kh[15]);
          *(LAS u32x4*)(lds + KHO + s * PR + kc * 32) = w0; *(LAS u32x4*)(lds + KHO + s * PR + kc * 32 + 16) = w1; }
        {
#pragma unroll
          for (int i = 0; i < 4; ++i) { const int pc = tid + NTHR * i, v = pc >> 4, k8 = pc & 15;
              const u32x4 sv = stv[i];
              const f32x4 r0 = *(const LAS f32x4*)(LB + mid * 128 + 8 * k8), r1 = *(const LAS f32x4*)(LB + mid * 128 + 8 * k8 + 4);
              u32x4 w; w.x = pk2(bflo(sv.x) * fexp(r0[0]), bfhi(sv.x) * fexp(r0[1])); w.y = pk2(bflo(sv.y) * fexp(r0[2]), bfhi(sv.y) * fexp(r0[3]));
              w.z = pk2(bflo(sv.z) * fexp(r1[0]), bfhi(sv.z) * fexp(r1[1])); w.w = pk2(bflo(sv.w) * fexp(r1[2]), bfhi(sv.w) * fexp(r1[3]));
              *(LAS u32x4*)(lds + STO + v * PR + k8 * 16) = w; } }
        __syncthreads();
        if (wid < 4) { const int sb = wid & 1, tb2 = wid >> 1;
            f32x16 a;
#pragma unroll
            for (int r = 0; r < 16; ++r) a[r] = 0.f;
            const LAS unsigned char* ka = lds + KHO + (32 * sb + r32) * PR + hi * 16;
            const LAS unsigned char* qa = lds + QHO + (32 * tb2 + r32) * PR + hi * 16;
#pragma unroll
            for (int kk = 0; kk < 8; ++kk) a = MFMA32(*(const LAS bf16x8*)(ka + kk * 32), *(const LAS bf16x8*)(qa + kk * 32), a);
            const int t = 32 * tb2 + r32;
#pragma unroll
            for (int rg = 0; rg < 4; ++rg) { const int s0 = 32 * sb + 8 * rg + 4 * hi; float v4[4];
#pragma unroll
                for (int j = 0; j < 4; ++j) { const int s = s0 + j; const bool keep = dir == 0 ? (s <= t) : (s >= t); v4[j] = keep ? a[4 * rg + j] : 0.f; }
                u32x2 w; w.x = pk2(v4[0], v4[1]); w.y = pk2(v4[2], v4[3]); *(LAS u32x2*)(lds + ATO + t * VROW + s0 * 2) = w; } }
        __syncthreads();
        { const LAS unsigned char* va = lds + VTO + (32 * vb + r32) * VROW + hi * 16;
          const LAS unsigned char* aa = lds + ATO + (32 * tb + r32) * VROW + hi * 16;
#pragma unroll
          for (int st = 0; st < 4; ++st) acc = MFMA32(*(const LAS bf16x8*)(va + st * 32), *(const LAS bf16x8*)(aa + st * 32), acc);
          const LAS unsigned char* sa = lds + STO + (32 * vb + r32) * PR + hi * 16;
          const LAS unsigned char* qa = lds + QHO + (32 * tb + r32) * PR + hi * 16;
#pragma unroll
          for (int kk = 0; kk < 8; ++kk) acc = MFMA32(*(const LAS bf16x8*)(sa + kk * 32), *(const LAS bf16x8*)(qa + kk * 32), acc); }
    }
    LAS float* SS = (LAS float*)(lds + SSO);
    { float ss = 0.f;
#pragma unroll
      for (int r = 0; r < 16; ++r) ss += acc[r] * acc[r];
      ss += __shfl_xor(ss, 32);
      if (hi == 0) SS[vb * 64 + 32 * tb + r32] = ss; }
    __syncthreads();
    { const int t = 32 * tb + r32; const float tot = SS[t] + SS[64 + t] + SS[128 + t] + SS[192 + t];
      const float rstd = __builtin_amdgcn_rsqf(tot * (1.f / 128.f) + EPS);
      const bf16_t* gp = Yb + (size_t)(64 * mb + t) * INW + C_HG + h * 128;
      bf16_t* op = YMb + (size_t)(64 * mb + t) * YMW + 512 + h * 128;
#pragma unroll
      for (int rg = 0; rg < 4; ++rg) { const int v0 = 32 * vb + 8 * rg + 4 * hi; const u32x2 gw = *(const u32x2*)(gp + v0); const f32x4 nw = *(const f32x4*)(hnorm + v0);
          u32x2 w; w.x = pk2(acc[4 * rg] * rstd * nw[0] * bflo(gw.x), acc[4 * rg + 1] * rstd * nw[1] * bfhi(gw.x));
          w.y = pk2(acc[4 * rg + 2] * rstd * nw[2] * bflo(gw.y), acc[4 * rg + 3] * rstd * nw[3] * bfhi(gw.y));
          *(u32x2*)(op + v0) = w; } }
    __syncthreads();
}


#define XB_TMO      128
#define XB_XCNT(j)  (256  + 64 * (j))
#define XB_XSUB(j)  (1280 + 64 * (j))
#define XB_XGEN(j)  (2304 + 64 * (j))
#define XB_TOP      3328
#define XB_TOPGEN   3392
#define XCD_BAR_WORDS 3456
#define XB_SPIN_CAP (1u << 22)
DI unsigned xb_ld(unsigned* p)              { return __hip_atomic_load(p, __ATOMIC_RELAXED, __HIP_MEMORY_SCOPE_AGENT); }
DI unsigned xb_add(unsigned* p, unsigned v) { return __hip_atomic_fetch_add(p, v, __ATOMIC_RELAXED, __HIP_MEMORY_SCOPE_AGENT); }
DI unsigned xb_xcc_id() { return (unsigned)__builtin_amdgcn_s_getreg((3 << 11) | 20) & 0xFu; }
#define XB_SPIN(cond, bar) do { unsigned _sp = 0; while (cond) { __builtin_amdgcn_s_sleep(1); \
    if ((++_sp & 255u) == 0u) { if (xb_ld(&(bar)[XB_TMO])) break; if (_sp > XB_SPIN_CAP) { atomicAdd(&(bar)[XB_TMO], 1u); break; } } } } while (0)
struct XcdBarrier { unsigned* bar; unsigned x; volatile LAS unsigned* st; };
DI XcdBarrier xcd_barrier_post(unsigned* bar, volatile LAS unsigned* st) {
    XcdBarrier b; b.bar = bar; b.x = xb_xcc_id(); b.st = st;
    if (threadIdx.x == 0) (void)xb_add(&bar[XB_XCNT(b.x)], 1u);
    return b;
}
DI void xcd_barrier_complete(unsigned* bar, unsigned x, unsigned& nloc, unsigned& nx) {
    const unsigned G = gridDim.x * gridDim.y * gridDim.z;
    unsigned sum, cnt, mine, sp = 0u;
    for (;;) {
        sum = 0u; cnt = 0u; mine = 0u;
#pragma unroll
        for (unsigned j = 0; j < 16; ++j) { const unsigned c = xb_ld(&bar[XB_XCNT(j)]); sum += c; cnt += (c > 0u) ? 1u : 0u; mine = (j == x) ? c : mine; }
        if (sum == G) break;
        __builtin_amdgcn_s_sleep(1);
        if ((++sp & 255u) == 0u) { if (xb_ld(&bar[XB_TMO])) break; if (sp > XB_SPIN_CAP) { atomicAdd(&bar[XB_TMO], 1u); break; } }
    }
    nloc = mine > 0u ? mine : 1u; nx = cnt > 0u ? cnt : 1u;
}
DI void xcd_barrier(const XcdBarrier& b) {
    asm volatile("s_waitcnt vmcnt(0)" ::: "memory");
    __syncthreads();
    if (threadIdx.x == 0) {
        unsigned* bar = b.bar;
        __builtin_amdgcn_s_waitcnt(0);
        unsigned nloc = b.st[0], nx = b.st[1];
        if (nloc == 0u) { xcd_barrier_complete(bar, b.x, nloc, nx); b.st[0] = nloc; b.st[1] = nx; }
        const unsigned old = xb_add(&bar[XB_XSUB(b.x)], 1u);
        const unsigned gen = old / nloc;
        if (old + 1u == (gen + 1u) * nloc) {
            __builtin_amdgcn_fence(__ATOMIC_RELEASE, "agent");
            asm volatile("s_waitcnt vmcnt(0)" ::: "memory");
            const unsigned og = xb_add(&bar[XB_TOP], 1u);
            const unsigned tg = og / nx;
            if (og + 1u == (tg + 1u) * nx) xb_add(&bar[XB_TOPGEN], 1u);
            else XB_SPIN(xb_ld(&bar[XB_TOPGEN]) == tg, bar);
            __builtin_amdgcn_fence(__ATOMIC_ACQUIRE, "agent");
            xb_add(&bar[XB_XGEN(b.x)], 1u);
            asm volatile("s_waitcnt vmcnt(0)" ::: "memory");
        } else {
            XB_SPIN(xb_ld(&bar[XB_XGEN(b.x)]) == gen, bar);
            __builtin_amdgcn_fence(__ATOMIC_ACQUIRE, "agent");
            asm volatile("s_waitcnt vmcnt(0)" ::: "memory");
        }
    }
    __syncthreads();
}

struct Args { Ptrs P; int ph_lo, ph_hi; };
constexpr int N_PHASES = 2 + DEPTH * 21;

__global__ void __launch_bounds__(NTHR, 2) fwd_kernel(Args args) {
    extern __shared__ __attribute__((aligned(16))) unsigned char lds_raw[];
    LAS unsigned char* lds = (LAS unsigned char*)lds_raw;
    const Ptrs& P = args.P;
    unsigned char* ws = P.ws;
    float* MODS = (float*)(ws + WS_MODS); float* cosT = (float*)(ws + WS_ROPE); float* sinT = cosT + 2048;
    float* CTXR = (float*)(ws + WS_CTXR);
    bf16_t* Wb = (bf16_t*)(ws + WS_W);
    bf16_t* Hb = (bf16_t*)(ws + WS_H); bf16_t* MG = (bf16_t*)(ws + WS_MG);
    unsigned char* big = ws + WS_BIG;
    bf16_t* Yb = (bf16_t*)(big + WB_Y); float* LOGF = (float*)(big + WB_LOGF); bf16_t* VTb = (bf16_t*)(big + WB_VT);
    bf16_t* Gs = (bf16_t*)(big + WB_G); bf16_t* STb = (bf16_t*)(big + WB_ST); float* DEC = (float*)(big + WB_DEC); bf16_t* YMb = (bf16_t*)(big + WB_YM);
    bf16_t* YOUT = (bf16_t*)(big); bf16_t* Ub = (bf16_t*)(big); bf16_t* Zb = MG;
    const int lo = args.ph_lo, hi = args.ph_hi;
    cg::grid_group grid = cg::this_grid();
    volatile LAS unsigned* bst = (volatile LAS unsigned*)(lds + LDS_BYTES - 64);
    if (threadIdx.x < 2) bst[threadIdx.x] = 0u;
    __syncthreads();
    XcdBarrier xbar; xbar.bar = (unsigned*)(ws + WS_BAR); xbar.x = 0; xbar.st = bst;
    if (hi - lo > 1) xbar = xcd_barrier_post((unsigned*)(ws + WS_BAR), bst);
#pragma clang loop unroll(disable)
    for (int ph = lo; ph < hi; ++ph) {
        int l = 0, b = 0, kind = 0;
        if (ph == 1) kind = 1;
        else if (ph > 1) { const int q = ph - 2; l = q / 21; const int r = q % 21;
            if (r < 16) { b = r >> 2; const int i = r & 3; kind = i < 2 ? 2 + i : 3 + i; } else kind = 7 + (r - 16); }
        asm volatile("" : "+s"(l), "+s"(b), "+s"(kind));
        const int tid = otid(), lane = tid & 63, wave = __builtin_amdgcn_readfirstlane(tid >> 6);
        int G = gridDim.x, bx = blockIdx.x; asm volatile("" : "+s"(G), "+s"(bx));
        const int gw = bx * 8 + wave, ngw = G * 8;
        const float* ng = P.norm_g + (size_t)l * 4 * DM;
        if (kind == 0) {
            if (bx == G - 1) { for (int i = tid; i < 2048; i += NTHR) { const int pos = i >> 4, f = i & 15; const float inv = ex2(-(float)f * (13.287712379549449f / 16.f)); const float ang = (float)pos * inv; cosT[i] = __cosf(ang); sinT[i] = __sinf(ang); } }
            for (int it = bx; it < 192; it += G) mods_item(P, it, lds, tid, wave, lane);
            __syncthreads();
            convert_weights(P, 0, lds, gw, ngw, wave, lane);
        } else if (kind == 1) {
            if (l == 0) {
                for (int R = gw; R < MT; R += ngw) { const int bb = R / RB, p = R % RB; const float* md = MODS + (size_t)(p < CTX ? 4 : bb) * 6144;
                    const float* src = p < CTX ? P.ctx + ((size_t)bb * CTX + p) * DM : P.x + ((size_t)bb * SEQ + (p - CTX)) * DM;
                    row_update<0>(src, nullptr, nullptr, nullptr, nullptr, ng, md, md + 1024, Hb + (size_t)R * DM, lane); }
            }
        } else if (kind == 2) {
            SchedWin S{(const char*)(Hb + (size_t)b * RB * DM), (const char*)(Wb + WO_IN / 2), G, bx};
            EpiWin E{Yb, LOGF, VTb, cosT, sinT, P.hgrn_lb, l};
            pg8::gemm_phase(lds, pg8::GemmDesc{DM, DM, DM}, S, E);
        } else if (kind == 3) {
                        for (int it = bx; it < 330; it += G) kmax_item(lds, Yb, (unsigned*)(ws + WS_BAR) + 5120 + (l * NB + b) * 16, it);
            __syncthreads();
#pragma clang loop unroll(disable)
            for (int v = bx; v < 4 * NCH; v += G) hgrn_pass1_unit(lds, Yb, VTb, Gs, DEC, v / NCH, v % NCH);
        } else if (kind == 5) {
            const float* dl = P.diff_lambda + l * 256;
            const float lam_init = l == 0 ? 0.2f : 0.35550906758f;
            const float lam = fexp(wave_sum(dl[lane] * dl[64 + lane])) - fexp(wave_sum(dl[128 + lane] * dl[192 + lane])) + lam_init;
            unsigned* sflag = (unsigned*)(ws + WS_BAR) + 4096 + 64 * (l * NB + b);
            for (int su = G - 1 - bx; su < 128; su += G) {
                hgrn_pass2(Gs, DEC, STb, su * 1024, su * 1024 + 1024, tid);
                asm volatile("s_waitcnt vmcnt(0)" ::: "memory");
                __syncthreads();
                if (tid == 0) { __builtin_amdgcn_fence(__ATOMIC_RELEASE, "agent"); asm volatile("s_waitcnt vmcnt(0)" ::: "memory"); xb_add(sflag, 1u); }
            }
            const int nl = bx < 256 ? (255 - bx) / G + 1 : 0;
#pragma clang loop unroll(disable)
            for (int k = 0; k < nl + 8; ++k) {
                int u; bool lat = true;
                if (k < nl) u = bx + k * G; else { const int v = k - nl; if (l == DEPTH - 1 || (120 + v) % G != bx) continue; u = v; lat = false; }
                const int uu = lat ? ((((u & 7) >> 1) << 6) | ((u & 1) << 5) | (u >> 3)) : u;
                diff_attn_unit(lds, Yb, VTb, YMb, lat ? (uu >> 6) : (uu >> 1), lat ? CTX + 128 * (uu & 63) : 128 * (uu & 1), lat ? RB : CTX, lam, P.diff_subln + l * 128, 1.f - lam_init, (const unsigned*)(ws + WS_BAR) + 5120 + (l * NB + b) * 16);
            }
            {   const int nls = bx < 256 ? (255 - bx) / G + 1 : 0;
#pragma clang loop unroll(disable)
                for (int k = 0; k < nls + 8; ++k) {
                    int u; if (k < nls) u = bx + k * G; else { const int e = k - nls; if (l == DEPTH - 1 || G - 1 - (16 + e) % G != bx) continue; u = 256 + e; }
                    const bool lat = u < 256; const int vv = lat ? u : u - 256;
                    swa_unit(lds, Yb, YMb, lat ? (vv >> 7) : (vv >> 2), lat ? (vv & 127) : (vv & 3), lat, P.swa_sink + l * 8, (const unsigned*)(ws + WS_BAR) + 5120 + (l * NB + b) * 16); } }
            {   if (tid == 0) { unsigned sp = 0; while (xb_ld(sflag) < 128u) { __builtin_amdgcn_s_sleep(2); if (++sp > (1u << 24)) break; }
                    __builtin_amdgcn_fence(__ATOMIC_ACQUIRE, "agent"); asm volatile("s_waitcnt vmcnt(0)" ::: "memory"); }
                __syncthreads(); }
#pragma clang loop unroll(disable)
            for (int v = bx; v < 4 * NCH; v += G) { if (l == DEPTH - 1 && v % NCH < 4) continue; hgrn_pass3_unit(lds, Yb, LOGF, VTb, STb, YMb, P.hgrn_norm + l * 128, v / NCH, v % NCH); }
        } else if (kind == 6) {
            SchedMerge S{(const char*)YMb, (const char*)(Wb + WO_BR / 2), bx, l == DEPTH - 1};
            EpiMerge E{Yb, Gs, MG + (size_t)b * RB * DM};
            pg8::gemm_phase(lds, pg8::GemmDesc{YMW, 512, 512}, S, E);
        } else if (kind == 7) {
            const bool sk = l == DEPTH - 1; SchedPlain S{(const char*)MG, (const char*)(Wb + WO_OUT / 2), sk ? 128 : MT / 256, DM / 256, DM, G, bx, sk};
            EpiStore<1> E{(void*)YOUT, DM};
            pg8::gemm_phase(lds, pg8::GemmDesc{DM, DM, DM}, S, E);
        } else if (kind == 8) {
            for (int R = gw; R < MT; R += ngw) { const int bb = R / RB, p = R % RB; const float* md = MODS + (size_t)(l * 5 + (p < CTX ? 4 : bb)) * 6144;
                if (l == DEPTH - 1 && p < CTX) continue;
                const float* rin; float* rout;
                if (p < CTX) { rout = CTXR + ((size_t)bb * CTX + p) * DM; rin = l == 0 ? P.ctx + ((size_t)bb * CTX + p) * DM : rout; }
                else { rout = P.out + ((size_t)bb * SEQ + (p - CTX)) * DM; rin = l == 0 ? P.x + ((size_t)bb * SEQ + (p - CTX)) * DM : rout; }
                row_update<2>(rin, rout, YOUT + (size_t)R * DM, md + 2048, ng + DM, ng + 2 * DM, md + 3072, md + 4096, Hb + (size_t)R * DM, lane); }
        } else if (kind == 9) {
            const bool sk = l == DEPTH - 1; SchedPlain S{(const char*)Hb, (const char*)(Wb + WO_UP / 2), sk ? 128 : MT / 256, FF / 256, DM, G, bx, sk};
            EpiStore<2> E{(void*)Ub, FF};
            pg8::gemm_phase(lds, pg8::GemmDesc{DM, DM, DM}, S, E);
        } else if (kind == 10) {
            const bool sk = l == DEPTH - 1; SchedPlain S{(const char*)Ub, (const char*)(Wb + WO_DN / 2), sk ? 128 : MT / 256, DM / 256, FF, G, bx, sk};
            EpiStore<1> E{(void*)Zb, DM};
            pg8::gemm_phase(lds, pg8::GemmDesc{FF, FF, FF}, S, E);
        } else {
            const bool more = l + 1 < DEPTH;
            const float* ngn = P.norm_g + (size_t)(more ? l + 1 : l) * 4 * DM;
            for (int R = gw; R < MT; R += ngw) { const int bb = R / RB, p = R % RB; const int vsel = p < CTX ? 4 : bb; const float* md = MODS + (size_t)(l * 5 + vsel) * 6144;
                if (!more && p < CTX) continue;
                float* rr = p < CTX ? CTXR + ((size_t)bb * CTX + p) * DM : P.out + ((size_t)bb * SEQ + (p - CTX)) * DM;
                const float* mdn = MODS + (size_t)((more ? l + 1 : l) * 5 + vsel) * 6144;
                row_update<2>(rr, rr, Zb + (size_t)R * DM, md + 5120, ng + 3 * DM, ngn, mdn, mdn + 1024, more ? Hb + (size_t)R * DM : nullptr, lane); }
            if (more) { __syncthreads(); convert_weights(P, l + 1, lds, gw, ngw, wave, lane); }
        }
        if (ph + 1 < hi) { if (hi < 0) grid.sync(); else xcd_barrier(xbar); }
    }
}

extern "C" void kernel_launch(void* const* d_in, const int* in_sizes, int n_in, void* d_out, int out_size, void* d_ws, size_t ws_size, hipStream_t stream) {
    static int grid = 0;
    if (grid == 0) {
        if (n_in != 17 || ws_size < WS_END) { fprintf(stderr, "kernel_launch: unexpected inputs (n_in %d, ws %zu, need %zu)\n", n_in, ws_size, (size_t)WS_END); grid = -1; return; }
        int dev = 0, cus = 0, per_cu = 0;
        hipGetDevice(&dev); hipDeviceGetAttribute(&cus, hipDeviceAttributeMultiprocessorCount, dev);
        hipFuncSetAttribute((const void*)fwd_kernel, hipFuncAttributeMaxDynamicSharedMemorySize, LDS_BYTES);
        hipOccupancyMaxActiveBlocksPerMultiprocessor(&per_cu, (const void*)fwd_kernel, NTHR, LDS_BYTES);
        if (per_cu < 1) per_cu = 1;
        (void)hipGetLastError();
        grid = cus * 1;
        if (grid > 256) grid = 256;
    }
    if (grid < 0) return;
    Args a{};
    const float** pp = (const float**)&a.P;
    for (int i = 0; i < 17; ++i) pp[i] = (const float*)d_in[i];
    a.P.out = (float*)d_out; a.P.ws = (unsigned char*)d_ws;
    (void)hipMemsetAsync((char*)d_ws + WS_BAR, 0, 32768, stream);
#if MK_ONE_LAUNCH
    a.ph_lo = 0; a.ph_hi = N_PHASES;
    void* kargs[] = {&a};
    hipError_t e = hipLaunchCooperativeKernel((const void*)fwd_kernel, dim3(grid), dim3(NTHR), kargs, LDS_BYTES, stream);
    if (e != hipSuccess) fprintf(stderr, "cooperative launch failed: %s (grid %d)\n", hipGetErrorString(e), grid);
#else
    for (int p = 0; p < N_PHASES; ++p) { a.ph_lo = p; a.ph_hi = p + 1; hipLaunchKernelGGL(fwd_kernel, dim3(grid), dim3(NTHR), LDS_BYTES, stream, a); }
#endif
}
```

```cpp
#include <hip/hip_runtime.h>
#include <hip/hip_cooperative_groups.h>
#include <cstdio>
#include <cstdint>
namespace cg = cooperative_groups;

#ifndef MK_ONE_LAUNCH
#define MK_ONE_LAUNCH 1
#endif

#ifndef DUP_MASK
#define DUP_MASK 0
#endif
#define DI __device__ __forceinline__
#define LAS __attribute__((address_space(3)))
typedef unsigned short bf16_t;
typedef short bf16x8 __attribute__((ext_vector_type(8)));
typedef float f32x4 __attribute__((ext_vector_type(4)));
typedef float f32x2 __attribute__((ext_vector_type(2)));
typedef float f32x16 __attribute__((ext_vector_type(16)));
typedef unsigned u32x4 __attribute__((ext_vector_type(4)));
typedef unsigned u32x2 __attribute__((ext_vector_type(2)));
typedef __bf16 bf16x2_t __attribute__((ext_vector_type(2)));

constexpr int DM = 1024, NB = 4, SEQ = 8192, CTX = 256, RB = SEQ + CTX, MT = NB * RB, INW = 7936, FF = 4096, DEPTH = 2;
constexpr int NCH = RB / 64;
constexpr float EPS = 1e-6f;
constexpr float LOG2E = 1.4426950408889634f;
constexpr float QSC = 0.125f * LOG2E;
constexpr int YMW = 1536;
constexpr int C_DQ = 0, C_DK = 512, C_DV = 1024, C_HQ = 1536, C_FF = 2048, C_FB = 2560, C_HI = 3072, C_HG = 3584, C_SQ = 4096, C_SK = 4608, C_SV = 4736, C_GT = 4864;

constexpr size_t MiB = 1u << 20;
constexpr size_t WS_MODS = 0;
constexpr size_t WS_ROPE = 256 * 1024;
constexpr size_t WS_BAR = 512 * 1024;
constexpr size_t WS_CTXR = 4 * MiB;
constexpr size_t WS_W = 8 * MiB;
constexpr size_t WO_IN = 0, WO_BR = 16 * MiB, WO_OUT = 19 * MiB, WO_UP = 21 * MiB, WO_DN = 29 * MiB;
constexpr size_t WS_H = 46 * MiB;
constexpr size_t WS_MG = 112 * MiB;
constexpr size_t WS_BIG = 178 * MiB;
constexpr size_t WB_Y = 0, WB_LOGF = 128 * MiB, WB_VT = 161 * MiB, WB_G = 178 * MiB, WB_ST = 244 * MiB, WB_DEC = 277 * MiB, WB_YM = 278 * MiB;
constexpr size_t WS_END = WS_BIG + 303 * MiB;

constexpr int LDS_BYTES = 147456;
constexpr int NTHR = 512;

DI unsigned pk2(float lo, float hi) { f32x2 v = {lo, hi}; bf16x2_t b = __builtin_convertvector(v, bf16x2_t); return __builtin_bit_cast(unsigned, b); }
DI float bflo(unsigned w) { return __uint_as_float(w << 16); }
DI float bfhi(unsigned w) { return __uint_as_float(w & 0xffff0000u); }
DI float ex2(float x) { return __builtin_amdgcn_exp2f(x); }
DI float fexp(float x) { return ex2(x * LOG2E); }
DI float sigm(float x) { return __builtin_amdgcn_rcpf(1.f + fexp(-x)); }
DI float wave_sum(float v) {
#pragma unroll
    for (int o = 1; o < 64; o <<= 1) v += __shfl_xor(v, o);
    return v;
}
DI int otid() { int t = threadIdx.x; asm volatile("" : "+v"(t)); return t; }
DI int swap23(int i) { return (i & 0x13) | ((i & 4) << 1) | ((i & 8) >> 1); }
#define MFMA32(a, b, c) __builtin_amdgcn_mfma_f32_32x32x16_bf16((a), (b), (c), 0, 0, 0)
DI bf16x8 pack8(const f32x16& x, int s) {
    u32x4 p; p.x = pk2(x[8 * s], x[8 * s + 1]); p.y = pk2(x[8 * s + 2], x[8 * s + 3]); p.z = pk2(x[8 * s + 4], x[8 * s + 5]); p.w = pk2(x[8 * s + 6], x[8 * s + 7]);
    return __builtin_bit_cast(bf16x8, p);
}

namespace pg8 {
constexpr int BM = 256, BK = 64, HALF = 128, HTB = HALF * BK * 2, STAGE_BYTES = 8 * HTB, NXCD = 8, WGM = 8;
DI int lds_byte(int r, int c) { const int st = (r >> 4) * 2 + (c >> 5), rr = r & 15, cc = c & 31, ob = rr * 64 + cc * 2; return st * 1024 + (ob ^ (((ob >> 9) & 1) << 5)); }
DI void stage_rc(int b, int& R, int& C) { const int st = b / 1024, sb = b % 1024, swz = sb ^ (((sb >> 9) & 1) << 5); R = (st >> 1) * 16 + swz / 64; C = (st & 1) * 32 + (swz % 64) / 2; }
DI int perm32(int rho) { const int n = rho >> 4, i = rho & 15; return 8 * (i >> 2) + 4 * n + (i & 3); }
struct Unit { int pm, pn, kind; };
struct GemmDesc { int lda, ldb, K; };
DI void tile_map(int L, int nM, int nN, int& pm, int& pn) {
    const int nwg = nM * nN; int wgid = L;
    { const int q = nwg / NXCD, r = nwg % NXCD, xcd = wgid % NXCD, off = wgid / NXCD; wgid = (xcd < r ? xcd * (q + 1) : r * (q + 1) + (xcd - r) * q) + off; }
    const int nig = WGM * nN, gid = wgid / nig, fm = gid * WGM, gsz = (nM - fm) < WGM ? (nM - fm) : WGM;
    pm = fm + ((wgid % nig) % gsz); pn = (wgid % nig) / gsz;
}

template <class Epi, class Sched>
DI void gemm_phase(LAS unsigned char* lds, const GemmDesc g, const Sched& S, const Epi& E) {
    const int tid = otid(), wid = __builtin_amdgcn_readfirstlane(tid >> 6), lane = tid & 63, wr = wid >> 2, wc = wid & 3, fr = lane & 15, fq = lane >> 4;
    const int K = g.K, nt = K / BK;
    unsigned voffA[2], voffB[2];
#pragma unroll
    for (int i = 0; i < 2; ++i) { int R, C; stage_rc(tid * 16 + i * 8192, R, C); const int Rb = (R & ~31) + perm32(R & 31);
        voffA[i] = (unsigned)(R * g.lda + C) * 2u; voffB[i] = (unsigned)(Rb * g.ldb + C) * 2u; }
    const size_t kstep = (size_t)(BK * 2);
    const size_t hstepA = (size_t)HALF * g.lda * 2, hstepB = (size_t)HALF * g.ldb * 2;
    const unsigned ldsw = (unsigned)wid * 1024u;
    const int aoff = lds_byte(wr * 64 + fr, fq * 8), boff = lds_byte(wc * 32 + fr, fq * 8);
#define PG8_SA(b, h) (((b) * 2 + (h)) * HTB)
#define PG8_SB(b, h) ((4 + (b) * 2 + (h)) * HTB)
#define PG8_STAGE(bufoff, gbase, voff) do { _Pragma("unroll") for (int _i = 0; _i < 2; ++_i) \
        __builtin_amdgcn_global_load_lds((const unsigned*)((const char*)(gbase) + (voff)[_i]), (LAS unsigned*)(lds + (bufoff) + ldsw + _i * 8192), 16, 0, 0); } while (0)
#define PG8_LDA(dst, b, h) do { _Pragma("unroll") for (int m = 0; m < 4; ++m) _Pragma("unroll") for (int k = 0; k < 2; ++k) dst[m][k] = *(const LAS bf16x8*)(lds + PG8_SA(b, h) + aoff + m * 2048 + k * 1024); } while (0)
#define PG8_LDB(dst, b, h) do { _Pragma("unroll") for (int n = 0; n < 2; ++n) _Pragma("unroll") for (int k = 0; k < 2; ++k) dst[n][k] = *(const LAS bf16x8*)(lds + PG8_SB(b, h) + boff + n * 2048 + k * 1024); } while (0)
#define PG8_MMA(ai, bj, At, Bt) do { __builtin_amdgcn_s_setprio(1); _Pragma("unroll") for (int m = 0; m < 4; ++m) _Pragma("unroll") for (int n = 0; n < 2; ++n) _Pragma("unroll") for (int k = 0; k < 2; ++k) \
        acc[ai][bj][m][n] = __builtin_amdgcn_mfma_f32_16x16x32_bf16(Bt[n][k], At[m][k], acc[ai][bj][m][n], 0, 0, 0); __builtin_amdgcn_s_setprio(0); } while (0)
#define PG8_WAIT_V(n) asm volatile("s_waitcnt vmcnt(" #n ")" ::: "memory")
#define PG8_WAIT_L(n) asm volatile("s_waitcnt lgkmcnt(" #n ")" ::: "memory")
#define PG8_BAR __builtin_amdgcn_s_barrier()
#define PG8_SCHED __builtin_amdgcn_sched_barrier(0)
    Unit cur, nxt; int ui = 0;
    if (!S.next(0, cur)) return;
    f32x4 acc[2][2][4][2];
#pragma unroll
    for (int a = 0; a < 2; ++a)
#pragma unroll
        for (int b = 0; b < 2; ++b)
#pragma unroll
            for (int m = 0; m < 4; ++m)
#pragma unroll
                for (int n = 0; n < 2; ++n) acc[a][b][m][n] = (f32x4){0.f, 0.f, 0.f, 0.f};
    bf16x8 At[4][2], B0[2][2], B1[2][2];
    const char* cA = S.a_ptr(cur); const char* cB = S.b_ptr(cur);
    PG8_STAGE(PG8_SB(0, 0), cB, voffB); PG8_STAGE(PG8_SB(0, 1), cB + hstepB, voffB); PG8_STAGE(PG8_SA(0, 0), cA, voffA); PG8_STAGE(PG8_SA(0, 1), cA + hstepA, voffA);
    if (wr == 1) PG8_BAR;
    PG8_WAIT_V(2); PG8_BAR;
    PG8_STAGE(PG8_SB(1, 0), cB + kstep, voffB); PG8_STAGE(PG8_SA(1, 0), cA + kstep, voffA); PG8_STAGE(PG8_SB(1, 1), cB + hstepB + kstep, voffB);
    PG8_WAIT_V(6); PG8_BAR;
    for (;;) {
        const bool has_next = S.next(ui + 1, nxt);
        const char* nA = has_next ? S.a_ptr(nxt) : cA; const char* nB = has_next ? S.b_ptr(nxt) : cB;
        for (int t = 0; t < nt; t += 2) {
            const bool last = (t == nt - 2);
            const char* a1 = cA + (size_t)(t + 1) * kstep;
            const char* a2 = last ? nA : cA + (size_t)(t + 2) * kstep; const char* b2 = last ? nB : cB + (size_t)(t + 2) * kstep;
            const char* a3 = a2 + kstep; const char* b3 = b2 + kstep;
            PG8_LDB(B0, 0, 0); PG8_LDB(B1, 0, 1); PG8_SCHED; PG8_LDA(At, 0, 0); PG8_STAGE(PG8_SA(1, 1), a1 + hstepA, voffA);
            PG8_WAIT_V(8); PG8_WAIT_L(0); PG8_BAR; PG8_MMA(0, 0, At, B0); PG8_MMA(0, 1, At, B1); PG8_BAR; PG8_SCHED;
            PG8_LDA(At, 0, 1); PG8_STAGE(PG8_SB(0, 0), b2, voffB); PG8_STAGE(PG8_SB(0, 1), b2 + hstepB, voffB); PG8_STAGE(PG8_SA(0, 0), a2, voffA);
            PG8_WAIT_V(8); PG8_WAIT_L(0); PG8_BAR; PG8_MMA(1, 0, At, B0); PG8_MMA(1, 1, At, B1); PG8_BAR; PG8_SCHED;
            PG8_LDB(B0, 1, 0); PG8_LDB(B1, 1, 1); PG8_SCHED; PG8_LDA(At, 1, 0); PG8_STAGE(PG8_SA(0, 1), a2 + hstepA, voffA);
            PG8_WAIT_V(8); PG8_WAIT_L(0); PG8_BAR; PG8_MMA(0, 0, At, B0); PG8_MMA(0, 1, At, B1); PG8_BAR; PG8_SCHED;
            PG8_LDA(At, 1, 1); PG8_STAGE(PG8_SB(1, 0), b3, voffB); PG8_STAGE(PG8_SB(1, 1), b3 + hstepB, voffB); PG8_STAGE(PG8_SA(1, 0), a3, voffA);
            PG8_WAIT_V(8); PG8_WAIT_L(0); PG8_BAR; PG8_MMA(1, 0, At, B0); PG8_MMA(1, 1, At, B1); PG8_BAR; PG8_SCHED;
        }
        if (wr == 0) PG8_BAR;
        E(acc, cur, wr, wc, fr, fq);
        if (!has_next) break;
#pragma unroll
        for (int a = 0; a < 2; ++a)
#pragma unroll
            for (int b = 0; b < 2; ++b)
#pragma unroll
                for (int m = 0; m < 4; ++m)
#pragma unroll
                    for (int n = 0; n < 2; ++n) acc[a][b][m][n] = (f32x4){0.f, 0.f, 0.f, 0.f};
        cur = nxt; cA = nA; cB = nB; ++ui;
        if (wr == 1) PG8_BAR;
    }
    PG8_WAIT_V(0);
    PG8_BAR;
#undef PG8_SA
#undef PG8_SB
#undef PG8_STAGE
#undef PG8_LDA
#undef PG8_LDB
#undef PG8_MMA
#undef PG8_WAIT_V
#undef PG8_WAIT_L
#undef PG8_BAR
#undef PG8_SCHED
}
}
using pg8::Unit;

struct SchedWin {
    const char* H; const char* W; int G, c;
    DI bool next(int i, Unit& u) const {
        const int L = i * G + c; if (L >= 1023) return false;
        if (L < 891) { int pm, lp; pg8::tile_map(L, 33, 27, pm, lp); u.pm = pm; u.pn = lp + (lp >= 4 ? 2 : 0) + (lp >= 10 ? 2 : 0); u.kind = 0; }
        else { const int Ls = L - 891; u.pm = Ls / 33; u.pn = Ls % 33; u.kind = 1; }
        return true;
    }
    DI const char* a_ptr(const Unit& u) const { return u.kind == 0 ? H + (size_t)u.pm * 256 * DM * 2 : W + (size_t)((u.pm < 2 ? C_DV : C_HI - 512) + u.pm * 256) * DM * 2; }
    DI const char* b_ptr(const Unit& u) const { return u.kind == 0 ? W + (size_t)u.pn * 256 * DM * 2 : H + (size_t)u.pn * 256 * DM * 2; }
};
struct SchedMerge {
    const char* YM; const char* WB; int c; bool skipctx;
    DI bool next(int i, Unit& u) const { if (i >= 3 || c >= 132 || (skipctx && c < 4)) return false; u.pm = c >> 2; u.pn = c & 3; u.kind = i; return true; }
    DI const char* a_ptr(const Unit& u) const { return YM + ((size_t)u.pm * 256 * YMW + u.kind * 512) * 2; }
    DI const char* b_ptr(const Unit& u) const { return WB + ((size_t)u.kind * DM * 512 + (size_t)u.pn * 256 * 512) * 2; }
};
struct SchedPlain {
    const char* A; const char* Bt; int nM, nN, K, G, c; bool skip;
    DI bool next(int i, Unit& u) const { const int L = i * G + c; if (L >= nM * nN) return false; pg8::tile_map(L, nM, nN, u.pm, u.pn); if (skip) u.pm += u.pm / 32 + 1; u.kind = 0; return true; }
    DI const char* a_ptr(const Unit& u) const { return A + (size_t)u.pm * 256 * K * 2; }
    DI const char* b_ptr(const Unit& u) const { return Bt + (size_t)u.pn * 256 * K * 2; }
};

struct EpiWin {
    bf16_t* Yb; float* LOGF; bf16_t* VT; const float* cosT; const float* sinT; const float* hlb; int layer;
    DI void operator()(const f32x4 (&acc)[2][2][4][2], const Unit& u, int wr, int wc, int fr, int fq) const {
        if (u.kind == 1) {
            const int row0 = u.pm * 256 + wr * 64 + fr, col0 = u.pn * 256 + wc * 32 + 8 * fq;
#pragma unroll
            for (int ai = 0; ai < 2; ++ai)
#pragma unroll
                for (int m = 0; m < 4; ++m) { bf16_t* rowp = VT + (size_t)(row0 + ai * 128 + m * 16) * RB + col0;
#pragma unroll
                    for (int bj = 0; bj < 2; ++bj) { const f32x4 v0 = acc[ai][bj][m][0], v1 = acc[ai][bj][m][1];
                        u32x4 w; w.x = pk2(v0[0], v0[1]); w.y = pk2(v0[2], v0[3]); w.z = pk2(v1[0], v1[1]); w.w = pk2(v1[2], v1[3]);
                        *(u32x4*)(rowp + bj * 128) = w; } }
            return;
        }
        const int pn = u.pn;
        if (layer == DEPTH - 1 && u.pm == 0 && (pn < 2 || pn == 6 || pn == 7 || (pn >= 14 && pn <= 17) || pn >= 19)) return;
        int type; float sc = 1.f;
        if (pn < 2) { type = 0; sc = QSC; } else if (pn < 4) type = 1; else if (pn < 8) type = 2; else if (pn < 12) type = 3; else if (pn < 16) type = 2;
        else if (pn < 18) { type = 0; sc = QSC; } else if (pn == 18) type = 4; else type = 5;
        const bool latent = (u.pm != 0);
        const int cbase = pn * 256 + wc * 32 + 8 * fq;
        float lbv[2][8];
        if (type == 3) {
#pragma unroll
            for (int bj = 0; bj < 2; ++bj)
#pragma unroll
                for (int j = 0; j < 8; ++j) { float lb = 0.f; if (layer == 1) { const int ci = cbase + bj * 128 + j - C_FF; const float a0 = hlb[ci], a1 = hlb[1024 + ci]; lb = __builtin_amdgcn_rcpf(1.f + fexp(a0 - a1)); } lbv[bj][j] = lb; }
        }
        const float sgn = (fq >> 1) ? 1.f : -1.f;
#pragma unroll
        for (int ai = 0; ai < 2; ++ai)
#pragma unroll
            for (int m = 0; m < 4; ++m) {
                const int rl = u.pm * 256 + ai * 128 + wr * 64 + m * 16 + fr;
                float cs[8], sn[8];
                const bool dorope = (type == 0 || type == 1 || type == 4) && latent;
                if (dorope) { const int t = rl - CTX; const int pos = (wc & 1) ? (t & 63) : (t >> 6); const int o = pos * 16 + 8 * (fq & 1);
                    const f32x4 c0 = *(const f32x4*)(cosT + o), c1 = *(const f32x4*)(cosT + o + 4), s0 = *(const f32x4*)(sinT + o), s1 = *(const f32x4*)(sinT + o + 4);
#pragma unroll
                    for (int j = 0; j < 4; ++j) { cs[j] = c0[j]; cs[4 + j] = c1[j]; sn[j] = s0[j]; sn[4 + j] = s1[j]; } }
#pragma unroll
                for (int bj = 0; bj < 2; ++bj) {
                    float v[8];
#pragma unroll
                    for (int j = 0; j < 4; ++j) { v[j] = acc[ai][bj][m][0][j]; v[4 + j] = acc[ai][bj][m][1][j]; }
                    const int col = cbase + bj * 128;
                    if (type == 3) {
                        float o8[8];
#pragma unroll
                        for (int j = 0; j < 8; ++j) { const float kg = (1.f - lbv[bj][j]) * sigm(-v[j]); o8[j] = __logf(1.f - kg); }
#pragma unroll
                        for (int j = 0; j < 8; ++j) v[j] = o8[j];
                    }
                    if (type == 3) { } else if (type == 0 || type == 1 || (type == 4 && bj == 0)) {
                        if (dorope) {
#pragma unroll
                            for (int j = 0; j < 8; ++j) { const float pr = __shfl_xor(v[j], 32); v[j] = v[j] * cs[j] + sgn * pr * sn[j]; }
                        }
#pragma unroll
                        for (int j = 0; j < 8; ++j) v[j] *= sc;
                    } else if (type == 2) {
#pragma unroll
                        for (int j = 0; j < 8; ++j) v[j] = v[j] * sigm(v[j]);
                    } else if (type == 5) {
#pragma unroll
                        for (int j = 0; j < 8; ++j) v[j] = sigm(v[j]);
                    }
                    u32x4 w; w.x = pk2(v[0], v[1]); w.y = pk2(v[2], v[3]); w.z = pk2(v[4], v[5]); w.w = pk2(v[6], v[7]);
                    *(u32x4*)(Yb + (size_t)rl * INW + col) = w;
                }
            }
    }
};
struct EpiMerge {
    const bf16_t* Yb; bf16_t* MS_unused; bf16_t* MG;
    template <int J> DI void body(const f32x4 (&acc)[2][2][4][2], const Unit& u, int wr, int wc, int fr, int fq) const {
        const unsigned cbase = u.pn * 256 + wc * 32 + 8 * fq;
        const unsigned row0 = u.pm * 256 + wr * 64 + fr;
#pragma unroll
        for (int ai = 0; ai < 2; ++ai)
#pragma unroll
            for (int m = 0; m < 4; ++m) { unsigned rl = row0 + ai * 128 + m * 16; asm volatile("" : "+v"(rl));
                const unsigned go = rl * INW + C_GT + J * 1024 + cbase, mo = rl * DM + cbase;
#pragma unroll
                for (int bj = 0; bj < 2; ++bj) {
                    const u32x4 gw = *(const u32x4*)(Yb + go + bj * 128);
                    const f32x4 a0 = acc[ai][bj][m][0], a1 = acc[ai][bj][m][1];
                    f32x4 v0 = {a0[0] * bflo(gw.x), a0[1] * bfhi(gw.x), a0[2] * bflo(gw.y), a0[3] * bfhi(gw.y)};
                    f32x4 v1 = {a1[0] * bflo(gw.z), a1[1] * bfhi(gw.z), a1[2] * bflo(gw.w), a1[3] * bfhi(gw.w)};
                    bf16_t* mg = MG + mo + bj * 128;
                    if (J > 0) { const u32x4 pw = *(const u32x4*)mg; v0 += (f32x4){bflo(pw.x), bfhi(pw.x), bflo(pw.y), bfhi(pw.y)}; v1 += (f32x4){bflo(pw.z), bfhi(pw.z), bflo(pw.w), bfhi(pw.w)}; }
                    u32x4 w; w.x = pk2(v0[0], v0[1]); w.y = pk2(v0[2], v0[3]); w.z = pk2(v1[0], v1[1]); w.w = pk2(v1[2], v1[3]); *(u32x4*)mg = w; }
                asm volatile("" ::: "memory"); }
    }
    DI void operator()(const f32x4 (&acc)[2][2][4][2], const Unit& u, int wr, int wc, int fr, int fq) const {
        if (u.kind == 0) body<0>(acc, u, wr, wc, fr, fq); else if (u.kind == 1) body<1>(acc, u, wr, wc, fr, fq); else body<2>(acc, u, wr, wc, fr, fq);
    }
};
template <int MODE  > struct EpiStore {
    void* O; int ldc;
    DI void operator()(const f32x4 (&acc)[2][2][4][2], const Unit& u, int wr, int wc, int fr, int fq) const {
        const int cbase = u.pn * 256 + wc * 32 + 8 * fq;
#pragma unroll
        for (int ai = 0; ai < 2; ++ai)
#pragma unroll
            for (int m = 0; m < 4; ++m) { const size_t r = (size_t)(u.pm * 256 + ai * 128 + wr * 64 + m * 16 + fr);
#pragma unroll
                for (int bj = 0; bj < 2; ++bj) { const int col = cbase + bj * 128; f32x4 v0 = acc[ai][bj][m][0], v1 = acc[ai][bj][m][1];
                    if (MODE == 0) { float* o = (float*)O + r * ldc + col; *(f32x4*)o = v0; *(f32x4*)(o + 4) = v1; }
                    else { if (MODE == 2) {
#pragma unroll
                            for (int q = 0; q < 4; ++q) { const float a = fmaxf(v0[q], 0.f), b = fmaxf(v1[q], 0.f); v0[q] = a * a; v1[q] = b * b; } }
                        u32x4 w; w.x = pk2(v0[0], v0[1]); w.y = pk2(v0[2], v0[3]); w.z = pk2(v1[0], v1[1]); w.w = pk2(v1[2], v1[3]); *(u32x4*)((bf16_t*)O + r * ldc + col) = w; } } }
    }
};

DI void transpose_item(const float* W, int K, int N, bf16_t* WT, LAS float* scr, int item, int lane) {
    const int nblk = N / 32, kb = item / nblk, nb = item % nblk, k0 = 64 * kb, n0 = 32 * nb;
#pragma unroll 8
    for (int i = 0; i < 32; ++i) { const int kk = 2 * i + (lane >> 5); scr[kk * 33 + (lane & 31)] = W[(size_t)(k0 + kk) * N + n0 + (lane & 31)]; }
    asm volatile("s_waitcnt lgkmcnt(0)" ::: "memory");
    const int c = lane & 7;
#pragma unroll
    for (int j = 0; j < 4; ++j) { const int n = (lane >> 3) + 8 * j; const LAS float* s = scr + (8 * c) * 33 + n;
        u32x4 o; o.x = pk2(s[0 * 33], s[1 * 33]); o.y = pk2(s[2 * 33], s[3 * 33]); o.z = pk2(s[4 * 33], s[5 * 33]); o.w = pk2(s[6 * 33], s[7 * 33]);
        *(u32x4*)(WT + (size_t)(n0 + n) * K + k0 + 8 * c) = o; }
    asm volatile("s_waitcnt lgkmcnt(0)" ::: "memory");
}
struct Ptrs {
    const float *x, *c, *ctx, *c_ctx, *w_ada, *b_ada, *norm_g, *w_in, *diff_lambda, *diff_subln, *hgrn_lb, *hgrn_norm, *swa_sink, *w_branch, *w_out, *w_up, *w_dn;
    float* out; unsigned char* ws;
};
DI void convert_weights(const Ptrs& P, int l, LAS unsigned char* lds, int gw, int ngw, int wave, int lane) {
    LAS float* scr = (LAS float*)(lds + wave * 16384);
    bf16_t* Wb = (bf16_t*)(P.ws + WS_W);
    constexpr int I_IN = 16 * (INW / 32), I_BR = 8 * 32, I_OUT = 16 * 32, I_UP = 16 * 128, I_DN = 64 * 32;
    constexpr int NIT = I_IN + 3 * I_BR + I_OUT + I_UP + I_DN;
    for (int it = gw; it < NIT; it += ngw) {
        int r = it;
        if (r < I_IN) { transpose_item(P.w_in + (size_t)l * DM * INW, DM, INW, Wb + WO_IN / 2, scr, r, lane); continue; } r -= I_IN;
        if (r < 3 * I_BR) { const int j = r / I_BR; transpose_item(P.w_branch + ((size_t)l * 3 + j) * 512 * DM, 512, DM, Wb + WO_BR / 2 + (size_t)j * DM * 512, scr, r % I_BR, lane); continue; } r -= 3 * I_BR;
        if (r < I_OUT) { transpose_item(P.w_out + (size_t)l * DM * DM, DM, DM, Wb + WO_OUT / 2, scr, r, lane); continue; } r -= I_OUT;
        if (r < I_UP) { transpose_item(P.w_up + (size_t)l * DM * FF, DM, FF, Wb + WO_UP / 2, scr, r, lane); continue; } r -= I_UP;
        transpose_item(P.w_dn + (size_t)l * FF * DM, FF, DM, Wb + WO_DN / 2, scr, r, lane);
    }
}
DI void mods_item(const Ptrs& P, int item, LAS unsigned char* lds, int tid, int wave, int lane) {
    LAS float* act = (LAS float*)lds;
    LAS float* red = (LAS float*)(lds + 20480);
    const int l = item / 96, cb = item % 96, n = cb * 64 + lane;
    for (int i = tid; i < 5 * 1024; i += NTHR) { const int v = i >> 10, k = i & 1023; const float cv = v < 4 ? P.c[v * 1024 + k] : P.c_ctx[k]; act[i] = cv * sigm(cv); }
    __syncthreads();
    float a0 = 0.f, a1 = 0.f, a2 = 0.f, a3 = 0.f, a4 = 0.f;
    const float* wp = P.w_ada + (size_t)l * DM * 6144 + n;
#pragma unroll 8
    for (int kk = 0; kk < 128; ++kk) { const int k = wave * 128 + kk; const float w = wp[(size_t)k * 6144];
        a0 += act[k] * w; a1 += act[1024 + k] * w; a2 += act[2048 + k] * w; a3 += act[3072 + k] * w; a4 += act[4096 + k] * w; }
    red[(wave * 5 + 0) * 64 + lane] = a0; red[(wave * 5 + 1) * 64 + lane] = a1; red[(wave * 5 + 2) * 64 + lane] = a2; red[(wave * 5 + 3) * 64 + lane] = a3; red[(wave * 5 + 4) * 64 + lane] = a4;
    __syncthreads();
    if (tid < 320) { const int v = tid >> 6, ln = tid & 63; float s = P.b_ada[l * 6144 + cb * 64 + ln];
#pragma unroll
        for (int w = 0; w < 8; ++w) s += red[(w * 5 + v) * 64 + ln];
        ((float*)(P.ws + WS_MODS))[(l * 5 + v) * 6144 + cb * 64 + ln] = s; }
    __syncthreads();
}
template <int ADD  >
DI void row_update(const float* res_in, float* res_out, const void* add_row, const float* gate, const float* gain_add,
                   const float* gain_h, const float* shift, const float* scale, bf16_t* hrow, int lane) {
    f32x4 v[4];
#pragma unroll
    for (int j = 0; j < 4; ++j) v[j] = *(const f32x4*)(res_in + 4 * lane + 256 * j);
    if (ADD != 0) {
        f32x4 y[4]; float ss = 0.f;
#pragma unroll
        for (int j = 0; j < 4; ++j) {
            if (ADD == 1) y[j] = *(const f32x4*)((const float*)add_row + 4 * lane + 256 * j);
            else { const u32x2 w = *(const u32x2*)((const bf16_t*)add_row + 4 * lane + 256 * j); y[j] = (f32x4){bflo(w.x), bfhi(w.x), bflo(w.y), bfhi(w.y)}; }
            ss += (y[j][0] * y[j][0] + y[j][1] * y[j][1]) + (y[j][2] * y[j][2] + y[j][3] * y[j][3]); }
        const float rstd = __builtin_amdgcn_rsqf(wave_sum(ss) * (1.f / DM) + EPS);
#pragma unroll
        for (int j = 0; j < 4; ++j) { const f32x4 gt = *(const f32x4*)(gate + 4 * lane + 256 * j), ga = *(const f32x4*)(gain_add + 4 * lane + 256 * j);
            v[j] += gt * (y[j] * rstd * ga); }
    }
    if (res_out) {
#pragma unroll
        for (int j = 0; j < 4; ++j) *(f32x4*)(res_out + 4 * lane + 256 * j) = v[j];
    }
    if (hrow) {
        float ss = 0.f;
#pragma unroll
        for (int j = 0; j < 4; ++j) ss += (v[j][0] * v[j][0] + v[j][1] * v[j][1]) + (v[j][2] * v[j][2] + v[j][3] * v[j][3]);
        const float rstd = __builtin_amdgcn_rsqf(wave_sum(ss) * (1.f / DM) + EPS);
#pragma unroll
        for (int j = 0; j < 4; ++j) { const f32x4 gh = *(const f32x4*)(gain_h + 4 * lane + 256 * j), sh = *(const f32x4*)(shift + 4 * lane + 256 * j), scl = *(const f32x4*)(scale + 4 * lane + 256 * j);
            const f32x4 h = (v[j] * rstd * gh) * (scl + 1.f) + sh;
            u32x2 w; w.x = pk2(h[0], h[1]); w.y = pk2(h[2], h[3]); *(u32x2*)(hrow + 4 * lane + 256 * j) = w; }
    }
}

DI void diff_attn_unit(LAS unsigned char* lds, const bf16_t* Yb, const bf16_t* VTb, bf16_t* YMb, int h, int q0, int nkeys, float lam, const float* subln, float oscale, const unsigned* kmaxp) {
    const int tid = otid(), lane = tid & 63, wid = __builtin_amdgcn_readfirstlane(tid >> 6), r32 = lane & 31, hi = lane >> 5;
    const int c = wid & 1, sub = wid >> 1;
    constexpr int KROW = 272, KBUF = 64 * KROW, VROW = 144, VBUF = 128 * VROW, VOFF = 2 * KBUF;
    const bf16_t* kg = Yb + C_DK + h * 128;
    const bf16_t* vg = VTb + (size_t)(h * 128) * RB;
    const int kr0 = tid >> 4, kc0 = tid & 15, vr0 = tid >> 3, vc0 = tid & 7;
    bf16x8 qf[4];
    { const bf16_t* qp = Yb + (size_t)(q0 + 32 * sub + r32) * INW + C_DQ + h * 128 + c * 64 + hi * 8;
#pragma unroll
      for (int d0 = 0; d0 < 4; ++d0) qf[d0] = *(const bf16x8*)(qp + 16 * d0); }
    bf16x8 qf4, kone, ones;
    { float ss = 0.f;
#pragma unroll
      for (int d0 = 0; d0 < 4; ++d0)
#pragma unroll
          for (int j = 0; j < 8; ++j) { const float v = __uint_as_float(((unsigned)(unsigned short)qf[d0][j]) << 16); ss += v * v; }
      ss += __shfl_xor(ss, 32);
      const float mub = sqrtf(ss) * __uint_as_float(kmaxp[h * 2 + c]) * 1.01f;
      const short e = hi == 0 ? (short)(pk2(-mub, 0.f) & 0xffffu) : (short)0, o1 = hi == 0 ? (short)0x3F80 : (short)0;
      qf4 = (bf16x8){e, 0, 0, 0, 0, 0, 0, 0}; kone = (bf16x8){o1, 0, 0, 0, 0, 0, 0, 0};
      ones = (bf16x8){(short)0x3F80, (short)0x3F80, (short)0x3F80, (short)0x3F80, (short)0x3F80, (short)0x3F80, (short)0x3F80, (short)0x3F80}; }
    f32x16 O[4], L;
#pragma unroll
    for (int r = 0; r < 16; ++r) { O[0][r] = 0.f; O[1][r] = 0.f; O[2][r] = 0.f; O[3][r] = 0.f; L[r] = 0.f; }
    const int NT = nkeys / 64;
    u32x4 kr[1][2], vr[1][2];
    f32x16 P0, P1;
#define DA_LOADK(S, t) do { kr[S][0] = *(const u32x4*)(kg + (size_t)((t) * 64 + kr0) * INW + kc0 * 8); kr[S][1] = *(const u32x4*)(kg + (size_t)((t) * 64 + kr0 + 32) * INW + kc0 * 8); } while (0)
#define DA_LOADV(S, t) do { vr[S][0] = *(const u32x4*)(vg + (size_t)vr0 * RB + (t) * 64 + vc0 * 8); vr[S][1] = *(const u32x4*)(vg + (size_t)(vr0 + 64) * RB + (t) * 64 + vc0 * 8); } while (0)
#define DA_STOREK(S, b) do { *(LAS u32x4*)(lds + (b) * KBUF + kr0 * KROW + kc0 * 16) = kr[S][0]; *(LAS u32x4*)(lds + (b) * KBUF + (kr0 + 32) * KROW + kc0 * 16) = kr[S][1]; } while (0)
#define DA_STOREV(S, b) do { *(LAS u32x4*)(lds + VOFF + (b) * VBUF + vr0 * VROW + vc0 * 16) = vr[S][0]; *(LAS u32x4*)(lds + VOFF + (b) * VBUF + (vr0 + 64) * VROW + vc0 * 16) = vr[S][1]; } while (0)
    const int kro = swap23(r32) * KROW + (c * 64 + 8 * hi) * 2;
    const int vro = VOFF + r32 * VROW + hi * 16;
    DA_LOADK(0, 0); DA_STOREK(0, 0);
    __syncthreads();
    {
        DA_LOADK(0, 1); DA_LOADV(0, 0);
        asm volatile("" ::: "memory");
        const LAS unsigned char* kb = lds + kro;
#pragma unroll
        for (int r = 0; r < 16; ++r) { P0[r] = 0.f; P1[r] = 0.f; }
        P0 = MFMA32(kone, qf4, P0); P1 = MFMA32(kone, qf4, P1);
#pragma unroll
        for (int d0 = 0; d0 < 4; ++d0) { const bf16x8 a0 = *(const LAS bf16x8*)(kb + d0 * 32), a1 = *(const LAS bf16x8*)(kb + 32 * KROW + d0 * 32);
            P0 = MFMA32(a0, qf[d0], P0); P1 = MFMA32(a1, qf[d0], P1); }
#pragma unroll
        for (int r = 0; r < 16; ++r) { P0[r] = ex2(P0[r]); P1[r] = ex2(P1[r]); }
        DA_STOREK(0, 1); DA_STOREV(0, 0);
        __syncthreads();
    }
#define DA_ITER(t, LS, SS) do { \
        const int b = (t) & 1; \
        if ((t) + 1 < NT) DA_LOADK(0, (t) + 1); \
        DA_LOADV(0, (t)); \
        asm volatile("" ::: "memory"); \
        const LAS unsigned char* kb = lds + b * KBUF + kro; \
        const LAS unsigned char* vb = lds + (b ^ 1) * VBUF + vro; \
        f32x16 s0, s1; \
        _Pragma("unroll") for (int r = 0; r < 16; ++r) { s0[r] = 0.f; s1[r] = 0.f; } \
        s0 = MFMA32(kone, qf4, s0); s1 = MFMA32(kone, qf4, s1); \
        _Pragma("unroll") for (int d0 = 0; d0 < 4; ++d0) { const bf16x8 a0 = *(const LAS bf16x8*)(kb + d0 * 32), a1 = *(const LAS bf16x8*)(kb + 32 * KROW + d0 * 32); \
            s0 = MFMA32(a0, qf[d0], s0); s1 = MFMA32(a1, qf[d0], s1); } \
        bf16x8 pf[4]; pf[0] = pack8(P0, 0); pf[1] = pack8(P0, 1); pf[2] = pack8(P1, 0); pf[3] = pack8(P1, 1); \
        _Pragma("unroll") for (int sp = 0; sp < 4; ++sp) { \
            _Pragma("unroll") for (int dvb = 0; dvb < 4; ++dvb) { const bf16x8 a = *(const LAS bf16x8*)(vb + dvb * 32 * VROW + sp * 32); O[dvb] = MFMA32(a, pf[sp], O[dvb]); } \
            L = MFMA32(ones, pf[sp], L); } \
        _Pragma("unroll") for (int r = 0; r < 16; ++r) { P0[r] = ex2(s0[r]); P1[r] = ex2(s1[r]); } \
        asm volatile("" : "+v"(P0), "+v"(P1)); \
        __builtin_amdgcn_sched_group_barrier(0x100, 4, 0); \
        __builtin_amdgcn_sched_group_barrier(0x008, 2, 0); \
        _Pragma("unroll") for (int i = 0; i < 8; ++i) { __builtin_amdgcn_sched_group_barrier(0x008, 1, 0); __builtin_amdgcn_sched_group_barrier(0x100, 1, 0); __builtin_amdgcn_sched_group_barrier(0x002, 2, 0); } \
        _Pragma("unroll") for (int i = 0; i < 12; ++i) { __builtin_amdgcn_sched_group_barrier(0x008, 1, 0); __builtin_amdgcn_sched_group_barrier(0x100, 1, 0); __builtin_amdgcn_sched_group_barrier(0x002, 2, 0); } \
        _Pragma("unroll") for (int i = 0; i < 8; ++i) { __builtin_amdgcn_sched_group_barrier(0x008, 1, 0); __builtin_amdgcn_sched_group_barrier(0x002, 1, 0); } \
        __builtin_amdgcn_sched_barrier(0); \
        if ((t) + 1 < NT) DA_STOREK(0, b ^ 1); \
        DA_STOREV(0, b); \
        __syncthreads(); \
    } while (0)
    if (wid >= 4) __builtin_amdgcn_s_setprio(1);
#pragma clang loop unroll(disable)
    for (int t = 1; t < NT; ++t) { DA_ITER(t, 0, 0); }
    __builtin_amdgcn_s_setprio(0);
#undef DA_ITER
    {
        const LAS unsigned char* vb = lds + ((NT - 1) & 1) * VBUF + vro;
        bf16x8 pf[4]; pf[0] = pack8(P0, 0); pf[1] = pack8(P0, 1); pf[2] = pack8(P1, 0); pf[3] = pack8(P1, 1);
#pragma unroll
        for (int sp = 0; sp < 4; ++sp) {
#pragma unroll
            for (int dvb = 0; dvb < 4; ++dvb) { const bf16x8 a = *(const LAS bf16x8*)(vb + dvb * 32 * VROW + sp * 32); O[dvb] = MFMA32(a, pf[sp], O[dvb]); }
            L = MFMA32(ones, pf[sp], L); }
    }
#undef DA_LOADK
#undef DA_LOADV
#undef DA_STOREK
#undef DA_STOREV
    __syncthreads();
    const float inv = __builtin_amdgcn_rcpf(L[0]);
    LAS float* ex = (LAS float*)lds;
    LAS float* sl = (LAS float*)(lds + 65536);
    if (tid < 128) sl[tid] = subln[tid];
    if (c == 1) {
#pragma unroll
        for (int dvb = 0; dvb < 4; ++dvb)
#pragma unroll
            for (int r = 0; r < 16; ++r) ex[((sub * 4 + dvb) * 16 + r) * 64 + lane] = O[dvb][r] * inv;
    }
    __syncthreads();
    if (c == 0) {
        float ss = 0.f;
#pragma unroll
        for (int dvb = 0; dvb < 4; ++dvb)
#pragma unroll
            for (int r = 0; r < 16; ++r) { const float o = O[dvb][r] * inv - lam * ex[((sub * 4 + dvb) * 16 + r) * 64 + lane]; O[dvb][r] = o; ss += o * o; }
        ss += __shfl_xor(ss, 32);
        const float rstd = __builtin_amdgcn_rsqf(ss * (1.f / 128.f) + EPS) * oscale;
        bf16_t* orow = YMb + (size_t)(q0 + 32 * sub + r32) * YMW + h * 128;
#pragma unroll
        for (int dvb = 0; dvb < 4; ++dvb)
#pragma unroll
            for (int rp = 0; rp < 2; ++rp) {
                u32x2 w[2];
#pragma unroll
                for (int q = 0; q < 2; ++q) { const int rg = 2 * rp + q; const int dv0 = 32 * dvb + 8 * rg + 4 * hi; const f32x4 g = *(const LAS f32x4*)(sl + dv0);
                    w[q].x = pk2(O[dvb][4 * rg] * rstd * g[0], O[dvb][4 * rg + 1] * rstd * g[1]); w[q].y = pk2(O[dvb][4 * rg + 2] * rstd * g[2], O[dvb][4 * rg + 3] * rstd * g[3]); }
                { auto r0 = __builtin_amdgcn_permlane32_swap(w[0].x, w[1].x, false, false); w[0].x = r0[0]; w[1].x = r0[1];
                  auto r1 = __builtin_amdgcn_permlane32_swap(w[0].y, w[1].y, false, false); w[0].y = r1[0]; w[1].y = r1[1]; }
                u32x4 o; o.x = w[0].x; o.y = w[0].y; o.z = w[1].x; o.w = w[1].y;
                *(u32x4*)(orow + 32 * dvb + 16 * rp + 8 * hi) = o; }
    }
    __syncthreads();
}
DI void kmax_item(LAS unsigned char* lds, const bf16_t* Yb, unsigned* kmaxp, int item) {
    const int tid = otid(), lane = tid & 63, wid = tid >> 6;
    const int hm = item / 33, rt = item % 33;
    const bf16_t* kp = Yb + (size_t)(rt * 256 + (tid >> 1)) * INW + (hm < 8 ? C_DK + hm * 64 : C_SK + (hm - 8) * 64) + (tid & 1) * 32;
    float ss = 0.f;
#pragma unroll
    for (int i = 0; i < 4; ++i) { const u32x4 w = *(const u32x4*)(kp + 8 * i);
        const float a0 = bflo(w.x), a1 = bfhi(w.x), a2 = bflo(w.y), a3 = bfhi(w.y), a4 = bflo(w.z), a5 = bfhi(w.z), a6 = bflo(w.w), a7 = bfhi(w.w);
        ss += (a0 * a0 + a1 * a1) + (a2 * a2 + a3 * a3) + (a4 * a4 + a5 * a5) + (a6 * a6 + a7 * a7); }
    ss += __shfl_xor(ss, 1);
#pragma unroll
    for (int o = 2; o < 64; o <<= 1) ss = fmaxf(ss, __shfl_xor(ss, o));
    LAS float* red = (LAS float*)lds;
    __syncthreads();
    if (lane == 0) red[wid] = ss;
    __syncthreads();
    if (tid == 0) { float mx = red[0];
#pragma unroll
        for (int w = 1; w < 8; ++w) mx = fmaxf(mx, red[w]);
        atomicMax(kmaxp + hm, __float_as_uint(sqrtf(mx))); }
}

DI void swa_unit(LAS unsigned char* lds, const bf16_t* Yb, bf16_t* YMb, int kvh, int qb, bool latent, const float* sink, const unsigned* kmaxp) {
    const int tid = otid(), lane = tid & 63, wid = __builtin_amdgcn_readfirstlane(tid >> 6), r32 = lane & 31, hi = lane >> 5;
    const int sub = wid & 1, hq = kvh * 4 + (wid >> 1);
    constexpr int ROW = 144, VOFF = 64 * ROW, BUF = 2 * 64 * ROW;
    const int q0 = latent ? CTX + 64 * qb : 64 * qb;
    const int srow = tid >> 3, spc = tid & 7;
    const int qpos = 64 * qb + 32 * sub + r32;
    const int wlo = 4 + (qb < 2 ? 2 - qb : 0), whi = latent ? 4 + (129 - qb < 4 ? 129 - qb : 4) : 3;
    bf16x8 qf[4];
    { const bf16_t* qp = Yb + (size_t)(q0 + 32 * sub + r32) * INW + C_SQ + hq * 64 + hi * 8;
#pragma unroll
      for (int d0 = 0; d0 < 4; ++d0) qf[d0] = *(const bf16x8*)(qp + 16 * d0); }
    float mub, l;
    { float ss = 0.f;
#pragma unroll
      for (int d0 = 0; d0 < 4; ++d0)
#pragma unroll
          for (int j = 0; j < 8; ++j) { const float v = __uint_as_float(((unsigned)(unsigned short)qf[d0][j]) << 16); ss += v * v; }
      ss += __shfl_xor(ss, 32);
      const float sk = sink[hq] * LOG2E;
      mub = fmaxf(sqrtf(ss) * __uint_as_float(kmaxp[8 + kvh]) * 1.01f, sk);
      l = hi == 0 ? ex2(sk - mub) : 0.f; }
    f32x16 O[2];
#pragma unroll
    for (int i = 0; i < 2; ++i)
#pragma unroll
        for (int r = 0; r < 16; ++r) O[i][r] = 0.f;
    u32x4 kv, vv;
#define SWA_LOAD(it_) do { const int kr_ = (it_) < 4 ? 64 * (it_) : CTX + 64 * qb - 128 + 64 * ((it_) - 4); \
        kv = *(const u32x4*)(Yb + (size_t)(kr_ + srow) * INW + C_SK + kvh * 64 + spc * 8); vv = *(const u32x4*)(Yb + (size_t)(kr_ + lane) * INW + C_SV + kvh * 64 + wid * 8); } while (0)
#define SWA_STORE(p_) do { *(LAS u32x4*)(lds + (p_) * BUF + srow * ROW + spc * 16) = kv; \
        LAS bf16_t* vt = (LAS bf16_t*)(lds + (p_) * BUF + VOFF) + wid * 8 * (ROW / 2) + lane; \
        vt[0 * (ROW / 2)] = (bf16_t)(vv.x & 0xffff); vt[1 * (ROW / 2)] = (bf16_t)(vv.x >> 16); vt[2 * (ROW / 2)] = (bf16_t)(vv.y & 0xffff); vt[3 * (ROW / 2)] = (bf16_t)(vv.y >> 16); \
        vt[4 * (ROW / 2)] = (bf16_t)(vv.z & 0xffff); vt[5 * (ROW / 2)] = (bf16_t)(vv.z >> 16); vt[6 * (ROW / 2)] = (bf16_t)(vv.w & 0xffff); vt[7 * (ROW / 2)] = (bf16_t)(vv.w >> 16); } while (0)
    SWA_LOAD(0); SWA_STORE(0);
    __syncthreads();
    int p = 0;
#pragma clang loop unroll(disable)
    for (int it = 0; it <= whi; it = (it == 3 ? wlo : it + 1)) {
        const int kp = 64 * qb - 128 + 64 * (it - 4);
        const int nx = it == 3 ? wlo : it + 1;
        if (nx <= whi) SWA_LOAD(nx);
        asm volatile("" ::: "memory");
        const LAS unsigned char* kb = lds + p * BUF + swap23(r32) * ROW + hi * 16;
        const LAS unsigned char* vb = lds + p * BUF + VOFF + r32 * ROW + hi * 16;
        f32x16 s0, s1;
#pragma unroll
        for (int r = 0; r < 16; ++r) { s0[r] = -mub; s1[r] = -mub; }
#pragma unroll
        for (int d0 = 0; d0 < 4; ++d0) { const bf16x8 k0 = *(const LAS bf16x8*)(kb + d0 * 32), k1 = *(const LAS bf16x8*)(kb + 32 * ROW + d0 * 32); s0 = MFMA32(k0, qf[d0], s0); s1 = MFMA32(k1, qf[d0], s1); }
        if (it >= 4) {
            const int dbase = kp + 8 * hi - qpos;
#pragma unroll
            for (int r = 0; r < 16; ++r) { const int d0 = dbase + (r & 3) + 4 * ((r >> 2) & 1) + 16 * ((r >> 3) & 1), d1 = d0 + 32;
                if (d0 > 128 || d0 < -128) s0[r] = -INFINITY; if (d1 > 128 || d1 < -128) s1[r] = -INFINITY; }
        }
        float ps = 0.f;
#pragma unroll
        for (int r = 0; r < 16; ++r) { s0[r] = ex2(s0[r]); s1[r] = ex2(s1[r]); ps += s0[r] + s1[r]; }
        l += ps;
        bf16x8 pf[4]; pf[0] = pack8(s0, 0); pf[1] = pack8(s0, 1); pf[2] = pack8(s1, 0); pf[3] = pack8(s1, 1);
#pragma unroll
        for (int dvb = 0; dvb < 2; ++dvb)
#pragma unroll
            for (int sp = 0; sp < 4; ++sp) { const bf16x8 a = *(const LAS bf16x8*)(vb + dvb * 32 * ROW + sp * 32); O[dvb] = MFMA32(a, pf[sp], O[dvb]); }
        if (nx <= whi) SWA_STORE(p ^ 1);
        __syncthreads();
        p ^= 1;
    }
#undef SWA_LOAD
#undef SWA_STORE
    const float lt = l + __shfl_xor(l, 32);
    const float inv = __builtin_amdgcn_rcpf(lt);
    bf16_t* orow = YMb + (size_t)(q0 + 32 * sub + r32) * YMW + 1024 + hq * 64;
#pragma unroll
    for (int dvb = 0; dvb < 2; ++dvb)
#pragma unroll
        for (int rg = 0; rg < 4; ++rg) { const int dv0 = 32 * dvb + 8 * rg + 4 * hi;
            u32x2 w; w.x = pk2(O[dvb][4 * rg] * inv, O[dvb][4 * rg + 1] * inv); w.y = pk2(O[dvb][4 * rg + 2] * inv, O[dvb][4 * rg + 3] * inv);
            *(u32x2*)(orow + dv0) = w; }
}

DI int hgrn_chunk(int mb, int dir) { return dir == 0 ? mb : (mb < 4 ? 3 - mb : 135 - mb); }
DI void hgrn_pass1_unit(LAS unsigned char* lds, const bf16_t* LOGF  , const bf16_t* VTb, bf16_t* G, float* DEC, int h, int mb) {
    const int tid = otid(), lane = tid & 63, wid = __builtin_amdgcn_readfirstlane(tid >> 6), r32 = lane & 31, hi = lane >> 5;
    LAS float* LB = (LAS float*)lds;
    constexpr int VTO = 65536, VROW = 144, KTO = VTO + 128 * VROW, KTB = 128 * VROW;
#pragma unroll
    for (int i = 0; i < 4; ++i) { const int idx = tid + NTHR * i, dir = idx >> 10, rem = idx & 1023, s = rem >> 4, k8 = rem & 15;
        const u32x4 w = *(const u32x4*)(LOGF + (size_t)(64 * mb + s) * INW + C_FF + dir * 512 + h * 128 + 8 * k8);
        LAS float* dst = LB + (dir * 64 + s) * 128 + 8 * k8;
        *(LAS f32x4*)dst = (f32x4){bflo(w.x), bfhi(w.x), bflo(w.y), bfhi(w.y)}; *(LAS f32x4*)(dst + 4) = (f32x4){bflo(w.z), bfhi(w.z), bflo(w.w), bfhi(w.w)}; }
#pragma unroll
    for (int i = 0; i < 2; ++i) { const int pc = tid + NTHR * i, v = pc >> 3, c8 = pc & 7;
        *(LAS u32x4*)(lds + VTO + v * VROW + c8 * 16) = *(const u32x4*)(VTb + (size_t)(512 + h * 128 + v) * RB + 64 * mb + 8 * c8); }
    __syncthreads();
    if (tid < 256) { const int dir = tid >> 7, k = tid & 127; float a = 0.f;
        LAS float* lb = LB + dir * 64 * 128 + k; float v[64];
#pragma unroll
        for (int s = 0; s < 64; ++s) v[s] = lb[s * 128];
        if (dir == 0) {
#pragma unroll
            for (int s = 0; s < 64; ++s) { a += v[s]; v[s] = a; } }
        else {
#pragma unroll
            for (int s = 63; s >= 0; --s) { a += v[s]; v[s] = a; } }
#pragma unroll
        for (int s = 0; s < 64; ++s) lb[s * 128] = v[s];
        DEC[((size_t)(h * 2 + dir) * NCH + hgrn_chunk(mb, dir)) * 128 + k] = fexp(a); }
    __syncthreads();
    { const int dir = tid >> 8, k = tid & 127, sh = (tid >> 7) & 1;
      const LAS float* lb = LB + dir * 64 * 128 + k;
      const float bl = dir == 0 ? lb[63 * 128] : lb[0];
      LAS unsigned* kt = (LAS unsigned*)(lds + KTO + dir * KTB + k * VROW);
#pragma unroll 4
      for (int sp = 0; sp < 16; ++sp) { const int s = 32 * sh + 2 * sp;
          const float b0 = lb[s * 128], b1 = lb[(s + 1) * 128];
          float lf0, lf1;
          if (dir == 0) { lf0 = s == 0 ? b0 : b0 - lb[(s - 1) * 128]; lf1 = b1 - b0; }
          else { lf1 = s + 1 == 63 ? b1 : b1 - lb[(s + 2) * 128]; lf0 = b0 - b1; }
          const float k0 = (1.f - fexp(lf0)) * fexp(bl - b0), k1 = (1.f - fexp(lf1)) * fexp(bl - b1);
          kt[s >> 1] = pk2(k0, k1); } }
    __syncthreads();
    { const int dir = wid >> 2, vb = wid & 3;
      f32x16 acc[4];
#pragma unroll
      for (int i = 0; i < 4; ++i)
#pragma unroll
          for (int r = 0; r < 16; ++r) acc[i][r] = 0.f;
      const LAS unsigned char* va = lds + VTO + (32 * vb + r32) * VROW + hi * 16;
      const LAS unsigned char* ka = lds + KTO + dir * KTB + r32 * VROW + hi * 16;
#pragma unroll
      for (int st = 0; st < 4; ++st) { const bf16x8 a = *(const LAS bf16x8*)(va + st * 32);
#pragma unroll
          for (int kb = 0; kb < 4; ++kb) { const bf16x8 b = *(const LAS bf16x8*)(ka + kb * 32 * VROW + st * 32); acc[kb] = MFMA32(a, b, acc[kb]); } }
      bf16_t* g = G + ((size_t)(h * 2 + dir) * NCH + hgrn_chunk(mb, dir)) * 16384;
#pragma unroll
      for (int kb = 0; kb < 4; ++kb)
#pragma unroll
          for (int r = 0; r < 16; ++r) { const int v = 32 * vb + (r & 3) + 8 * (r >> 2) + 4 * hi; g[v * 128 + 32 * kb + r32] = (bf16_t)(pk2(acc[kb][r], 0.f) & 0xffffu); } }
    __syncthreads();
}
DI void hgrn_pass2(const bf16_t* G, const float* DEC, bf16_t* ST, int e0, int e1, int tid) {
    for (int e = e0 + 2 * tid; e < e1; e += 2 * NTHR) {
        const int ch = e >> 14, vk = e & 16383, k = vk & 127;
        const bf16_t* g = G + (size_t)ch * NCH * 16384 + vk; const float* d = DEC + (size_t)ch * NCH * 128 + k; bf16_t* st = ST + (size_t)ch * NCH * 16384 + vk;
        float S0 = 0.f, S1 = 0.f;
        for (int n0 = 0; n0 < NCH; n0 += 33) {
            unsigned gv[33]; f32x2 dv[33];
#pragma unroll
            for (int j = 0; j < 33; ++j) { gv[j] = *(const unsigned*)(g + (size_t)(n0 + j) * 16384); dv[j] = *(const f32x2*)(d + (n0 + j) * 128); }
#pragma unroll
            for (int j = 0; j < 33; ++j) { *(unsigned*)(st + (size_t)(n0 + j) * 16384) = pk2(S0, S1); S0 = dv[j][0] * S0 + bflo(gv[j]); S1 = dv[j][1] * S1 + bfhi(gv[j]); }
        }
    }
}
DI void hgrn_pass3_unit(LAS unsigned char* lds, const bf16_t* Yb, const float* LOGF, const bf16_t* VTb, const bf16_t* ST, bf16_t* YMb, const float* hnorm, int h, int mb) {
    const int tid = otid(), lane = tid & 63, wid = __builtin_amdgcn_readfirstlane(tid >> 6), r32 = lane & 31, hi = lane >> 5;
    LAS float* LB = (LAS float*)lds;
    constexpr int PR = 272, QHO = 32768, KHO = QHO + 64 * PR, STO = KHO + 64 * PR, VTO = STO + 128 * PR, VROW = 144, ATO = VTO + 128 * VROW, SSO = ATO + 64 * VROW;
    const int tb = wid & 1, vb = wid >> 1;
    f32x16 acc;
#pragma unroll
    for (int r = 0; r < 16; ++r) acc[r] = 0.f;
#pragma unroll
    for (int i = 0; i < 2; ++i) { const int pc = tid + NTHR * i, v = pc >> 3, c8 = pc & 7;
        *(LAS u32x4*)(lds + VTO + v * VROW + c8 * 16) = *(const u32x4*)(VTb + (size_t)(512 + h * 128 + v) * RB + 64 * mb + 8 * c8); }
#pragma unroll 1
    for (int dir = 0; dir < 2; ++dir) {
        u32x4 lg[2]; u32x4 qq0, qq1, stv[4];
#pragma unroll
        for (int i = 0; i < 2; ++i) { const int idx = tid + NTHR * i, s = idx >> 4, k8 = idx & 15;
            lg[i] = *(const u32x4*)(Yb + (size_t)(64 * mb + s) * INW + C_FF + dir * 512 + h * 128 + 8 * k8); }
        { const bf16_t* qp = Yb + (size_t)(64 * mb + (tid >> 3)) * INW + C_HQ + h * 128 + 16 * (tid & 7); qq0 = *(const u32x4*)qp; qq1 = *(const u32x4*)(qp + 8); }
        { const bf16_t* st = ST + ((size_t)(h * 2 + dir) * NCH + hgrn_chunk(mb, dir)) * 16384;
#pragma unroll
          for (int i = 0; i < 4; ++i) { const int pc = tid + NTHR * i; stv[i] = *(const u32x4*)(st + (pc >> 4) * 128 + (pc & 15) * 8); } }
        asm volatile("" ::: "memory");
        __syncthreads();
#pragma unroll
        for (int i = 0; i < 2; ++i) { const int idx = tid + NTHR * i, s = idx >> 4, k8 = idx & 15; const u32x4 w = lg[i];
            LAS float* dst = LB + s * 128 + 8 * k8;
            *(LAS f32x4*)dst = (f32x4){bflo(w.x), bfhi(w.x), bflo(w.y), bfhi(w.y)}; *(LAS f32x4*)(dst + 4) = (f32x4){bflo(w.z), bfhi(w.z), bflo(w.w), bfhi(w.w)}; }
        __syncthreads();
        if (tid < 128) { float a = 0.f; LAS float* lb = LB + tid; float v[64];
#pragma unroll
            for (int s = 0; s < 64; ++s) v[s] = lb[s * 128];
            if (dir == 0) {
#pragma unroll
                for (int s = 0; s < 64; ++s) { a += v[s]; v[s] = a; } }
            else {
#pragma unroll
                for (int s = 63; s >= 0; --s) { a += v[s]; v[s] = a; } }
#pragma unroll
            for (int s = 0; s < 64; ++s) lb[s * 128] = v[s]; }
        __syncthreads();
        const int mid = dir == 0 ? 31 : 32;
        { const int s = tid >> 3, kc = tid & 7;
          const u32x4 q0 = qq0, q1 = qq1;
          float qv[16] = {bflo(q0.x), bfhi(q0.x), bflo(q0.y), bfhi(q0.y), bflo(q0.z), bfhi(q0.z), bflo(q0.w), bfhi(q0.w), bflo(q1.x), bfhi(q1.x), bflo(q1.y), bfhi(q1.y), bflo(q1.z), bfhi(q1.z), bflo(q1.w), bfhi(q1.w)};
          float qh[16], kh[16];
          const int sn = dir == 0 ? s - 1 : s + 1; const bool edge = dir == 0 ? (s == 0) : (s == 63);
#pragma unroll
          for (int j4 = 0; j4 < 4; ++j4) { const f32x4 b = *(const LAS f32x4*)(LB + s * 128 + 16 * kc + 4 * j4), rr = *(const LAS f32x4*)(LB + mid * 128 + 16 * kc + 4 * j4);
              f32x4 bn = {0.f, 0.f, 0.f, 0.f}; if (!edge) bn = *(const LAS f32x4*)(LB + sn * 128 + 16 * kc + 4 * j4);
#pragma unroll
              for (int j = 0; j < 4; ++j) { const float lf = b[j] - bn[j]; qh[4 * j4 + j] = qv[4 * j4 + j] * fexp(fminf(b[j] - rr[j], 80.f)); kh[4 * j4 + j] = (1.f - fexp(lf)) * fexp(fminf(rr[j] - b[j], 80.f)); } }
          u32x4 w0, w1;
          w0.x = pk2(qh[0], qh[1]); w0.y = pk2(qh[2], qh[3]); w0.z = pk2(qh[4], qh[5]); w0.w = pk2(qh[6], qh[7]); w1.x = pk2(qh[8], qh[9]); w1.y = pk2(qh[10], qh[11]); w1.z = pk2(qh[12], qh[13]); w1.w = pk2(qh[14], qh[15]);
          *(LAS u32x4*)(lds + QHO + s * PR + kc * 32) = w0; *(LAS u32x4*)(lds + QHO + s * PR + kc * 32 + 16) = w1;
          w0.x = pk2(kh[0], kh[1]); w0.y = pk2(kh[2], kh[3]); w0.z = pk2(kh[4], kh[5]); w0.w = pk2(kh[6], kh[7]); w1.x = pk2(kh[8], kh[9]); w1.y = pk2(kh[10], kh[11]); w1.z = pk2(kh[12], kh[13]); w1.w = pk2(kh[14], kh[15]);
          *(LAS u32x4*)(lds + KHO + s * PR + kc * 32) = w0; *(LAS u32x4*)(lds + KHO + s * PR + kc * 32 + 16) = w1; }
        {
#pragma unroll
          for (int i = 0; i < 4; ++i) { const int pc = tid + NTHR * i, v = pc >> 4, k8 = pc & 15;
              const u32x4 sv = stv[i];
              const f32x4 r0 = *(const LAS f32x4*)(LB + mid * 128 + 8 * k8), r1 = *(const LAS f32x4*)(LB + mid * 128 + 8 * k8 + 4);
              u32x4 w; w.x = pk2(bflo(sv.x) * fexp(r0[0]), bfhi(sv.x) * fexp(r0[1])); w.y = pk2(bflo(sv.y) * fexp(r0[2]), bfhi(sv.y) * fexp(r0[3]));
              w.z = pk2(bflo(sv.z) * fexp(r1[0]), bfhi(sv.z) * fexp(r1[1])); w.w = pk2(bflo(sv.w) * fexp(r1[2]), bfhi(sv.w) * fexp(r1[3]));
              *(LAS u32x4*)(lds + STO + v * PR + k8 * 16) = w; } }
        __syncthreads();
        if (wid < 4) { const int sb = wid & 1, tb2 = wid >> 1;
            f32x16 a;
#pragma unroll
            for (int r = 0; r < 16; ++r) a[r] = 0.f;
            const LAS unsigned char* ka = lds + KHO + (32 * sb + r32) * PR + hi * 16;
            const LAS unsigned char* qa = lds + QHO + (32 * tb2 + r32) * PR + hi * 16;
#pragma unroll
            for (int kk = 0; kk < 8; ++kk) a = MFMA32(*(const LAS bf16x8*)(ka + kk * 32), *(const LAS bf16x8*)(qa + kk * 32), a);
            const int t = 32 * tb2 + r32;
#pragma unroll
            for (int rg = 0; rg < 4; ++rg) { const int s0 = 32 * sb + 8 * rg + 4 * hi; float v4[4];
#pragma unroll
                for (int j = 0; j < 4; ++j) { const int s = s0 + j; const bool keep = dir == 0 ? (s <= t) : (s >= t); v4[j] = keep ? a[4 * rg + j] : 0.f; }
                u32x2 w; w.x = pk2(v4[0], v4[1]); w.y = pk2(v4[2], v4[3]); *(LAS u32x2*)(lds + ATO + t * VROW + s0 * 2) = w; } }
        __syncthreads();
        { const LAS unsigned char* va = lds + VTO + (32 * vb + r32) * VROW + hi * 16;
          const LAS unsigned char* aa = lds + ATO + (32 * tb + r32) * VROW + hi * 16;
#pragma unroll
          for (int st = 0; st < 4; ++st) acc = MFMA32(*(const LAS bf16x8*)(va + st * 32), *(const LAS bf16x8*)(aa + st * 32), acc);
          const LAS unsigned char* sa = lds + STO + (32 * vb + r32) * PR + hi * 16;
          const LAS unsigned char* qa = lds + QHO + (32 * tb + r32) * PR + hi * 16;
#pragma unroll
          for (int kk = 0; kk < 8; ++kk) acc = MFMA32(*(const LAS bf16x8*)(sa + kk * 32), *(const LAS bf16x8*)(qa + kk * 32), acc); }
    }
    LAS float* SS = (LAS float*)(lds + SSO);
    { float ss = 0.f;
#pragma unroll
      for (int r = 0; r < 16; ++r) ss += acc[r] * acc[r];
      ss += __shfl_xor(ss, 32);
      if (hi == 0) SS[vb * 64 + 32 * tb + r32] = ss; }
    __syncthreads();
    { const int t = 32 * tb + r32; const float tot = SS[t] + SS[64 + t] + SS[128 + t] + SS[192 + t];
      const float rstd = __builtin_amdgcn_rsqf(tot * (1.f / 128.f) + EPS);
      const bf16_t* gp = Yb + (size_t)(64 * mb + t) * INW + C_HG + h * 128;
      bf16_t* op = YMb + (size_t)(64 * mb + t) * YMW + 512 + h * 128;
#pragma unroll
      for (int rg = 0; rg < 4; ++rg) { const int v0 = 32 * vb + 8 * rg + 4 * hi; const u32x2 gw = *(const u32x2*)(gp + v0); const f32x4 nw = *(const f32x4*)(hnorm + v0);
          u32x2 w; w.x = pk2(acc[4 * rg] * rstd * nw[0] * bflo(gw.x), acc[4 * rg + 1] * rstd * nw[1] * bfhi(gw.x));
          w.y = pk2(acc[4 * rg + 2] * rstd * nw[2] * bflo(gw.y), acc[4 * rg + 3] * rstd * nw[3] * bfhi(gw.y));
          *(u32x2*)(op + v0) = w; } }
    __syncthreads();
}


#define XB_TMO      128
#define XB_XCNT(j)  (256  + 64 * (j))
#define XB_XSUB(j)  (1280 + 64 * (j))
#define XB_XGEN(j)  (2304 + 64 * (j))
#define XB_TOP      3328
#define XB_TOPGEN   3392
#define XCD_BAR_WORDS 3456
#define XB_SPIN_CAP (1u << 22)
DI unsigned xb_ld(unsigned* p)              { return __hip_atomic_load(p, __ATOMIC_RELAXED, __HIP_MEMORY_SCOPE_AGENT); }
DI unsigned xb_add(unsigned* p, unsigned v) { return __hip_atomic_fetch_add(p, v, __ATOMIC_RELAXED, __HIP_MEMORY_SCOPE_AGENT); }
DI unsigned xb_xcc_id() { return (unsigned)__builtin_amdgcn_s_getreg((3 << 11) | 20) & 0xFu; }
#define XB_SPIN(cond, bar) do { unsigned _sp = 0; while (cond) { __builtin_amdgcn_s_sleep(1); \
    if ((++_sp & 255u) == 0u) { if (xb_ld(&(bar)[XB_TMO])) break; if (_sp > XB_SPIN_CAP) { atomicAdd(&(bar)[XB_TMO], 1u); break; } } } } while (0)
struct XcdBarrier { unsigned* bar; unsigned x; volatile LAS unsigned* st; };
DI XcdBarrier xcd_barrier_post(unsigned* bar, volatile LAS unsigned* st) {
    XcdBarrier b; b.bar = bar; b.x = xb_xcc_id(); b.st = st;
    if (threadIdx.x == 0) (void)xb_add(&bar[XB_XCNT(b.x)], 1u);
    return b;
}
DI void xcd_barrier_complete(unsigned* bar, unsigned x, unsigned& nloc, unsigned& nx) {
    const unsigned G = gridDim.x * gridDim.y * gridDim.z;
    unsigned sum, cnt, mine, sp = 0u;
    for (;;) {
        sum = 0u; cnt = 0u; mine = 0u;
#pragma unroll
        for (unsigned j = 0; j < 16; ++j) { const unsigned c = xb_ld(&bar[XB_XCNT(j)]); sum += c; cnt += (c > 0u) ? 1u : 0u; mine = (j == x) ? c : mine; }
        if (sum == G) break;
        __builtin_amdgcn_s_sleep(1);
        if ((++sp & 255u) == 0u) { if (xb_ld(&bar[XB_TMO])) break; if (sp > XB_SPIN_CAP) { atomicAdd(&bar[XB_TMO], 1u); break; } }
    }
    nloc = mine > 0u ? mine : 1u; nx = cnt > 0u ? cnt : 1u;
}
DI void xcd_barrier(const XcdBarrier& b) {
    asm volatile("s_waitcnt vmcnt(0)" ::: "memory");
    __syncthreads();
    if (threadIdx.x == 0) {
        unsigned* bar = b.bar;
        __builtin_amdgcn_s_waitcnt(0);
        unsigned nloc = b.st[0], nx = b.st[1];
        if (nloc == 0u) { xcd_barrier_complete(bar, b.x, nloc, nx); b.st[0] = nloc; b.st[1] = nx; }
        const unsigned old = xb_add(&bar[XB_XSUB(b.x)], 1u);
        const unsigned gen = old / nloc;
        if (old + 1u == (gen + 1u) * nloc) {
            __builtin_amdgcn_fence(__ATOMIC_RELEASE, "agent");
            asm volatile("s_waitcnt vmcnt(0)" ::: "memory");
            const unsigned og = xb_add(&bar[XB_TOP], 1u);
            const unsigned tg = og / nx;
            if (og + 1u == (tg + 1u) * nx) xb_add(&bar[XB_TOPGEN], 1u);
            else XB_SPIN(xb_ld(&bar[XB_TOPGEN]) == tg, bar);
            __builtin_amdgcn_fence(__ATOMIC_ACQUIRE, "agent");
            xb_add(&bar[XB_XGEN(b.x)], 1u);
            asm volatile("s_waitcnt vmcnt(0)" ::: "memory");
        } else {
            XB_SPIN(xb_ld(&bar[XB_XGEN(b.x)]) == gen, bar);
            __builtin_amdgcn_fence(__ATOMIC_ACQUIRE, "agent");
            asm volatile("s_waitcnt vmcnt(0)" ::: "memory");
        }
    }
    __syncthreads();
}

struct Args { Ptrs P; int ph_lo, ph_hi; };
constexpr int N_PHASES = 2 + DEPTH * 21;

__global__ void __launch_bounds__(NTHR, 2) fwd_kernel(Args args) {
    extern __shared__ __attribute__((aligned(16))) unsigned char lds_raw[];
    LAS unsigned char* lds = (LAS unsigned char*)lds_raw;
    const Ptrs& P = args.P;
    unsigned char* ws = P.ws;
    float* MODS = (float*)(ws + WS_MODS); float* cosT = (float*)(ws + WS_ROPE); float* sinT = cosT + 2048;
    float* CTXR = (float*)(ws + WS_CTXR);
    bf16_t* Wb = (bf16_t*)(ws + WS_W);
    bf16_t* Hb = (bf16_t*)(ws + WS_H); bf16_t* MG = (bf16_t*)(ws + WS_MG);
    unsigned char* big = ws + WS_BIG;
    bf16_t* Yb = (bf16_t*)(big + WB_Y); float* LOGF = (float*)(big + WB_LOGF); bf16_t* VTb = (bf16_t*)(big + WB_VT);
    bf16_t* Gs = (bf16_t*)(big + WB_G); bf16_t* STb = (bf16_t*)(big + WB_ST); float* DEC = (float*)(big + WB_DEC); bf16_t* YMb = (bf16_t*)(big + WB_YM);
    bf16_t* YOUT = (bf16_t*)(big); bf16_t* Ub = (bf16_t*)(big); bf16_t* Zb = MG;
    const int lo = args.ph_lo, hi = args.ph_hi;
    cg::grid_group grid = cg::this_grid();
    volatile LAS unsigned* bst = (volatile LAS unsigned*)(lds + LDS_BYTES - 64);
    if (threadIdx.x < 2) bst[threadIdx.x] = 0u;
    __syncthreads();
    XcdBarrier xbar; xbar.bar = (unsigned*)(ws + WS_BAR); xbar.x = 0; xbar.st = bst;
    if (hi - lo > 1) xbar = xcd_barrier_post((unsigned*)(ws + WS_BAR), bst);
#pragma clang loop unroll(disable)
    for (int ph = lo; ph < hi; ++ph) {
        int l = 0, b = 0, kind = 0;
        if (ph == 1) kind = 1;
        else if (ph > 1) { const int q = ph - 2; l = q / 21; const int r = q % 21;
            if (r < 16) { b = r >> 2; const int i = r & 3; kind = i < 2 ? 2 + i : 3 + i; } else kind = 7 + (r - 16); }
        asm volatile("" : "+s"(l), "+s"(b), "+s"(kind));
        const int tid = otid(), lane = tid & 63, wave = __builtin_amdgcn_readfirstlane(tid >> 6);
        int G = gridDim.x, bx = blockIdx.x; asm volatile("" : "+s"(G), "+s"(bx));
        const int gw = bx * 8 + wave, ngw = G * 8;
        const float* ng = P.norm_g + (size_t)l * 4 * DM;
        if (kind == 0) {
            if (bx == G - 1) { for (int i = tid; i < 2048; i += NTHR) { const int pos = i >> 4, f = i & 15; const float inv = ex2(-(float)f * (13.287712379549449f / 16.f)); const float ang = (float)pos * inv; cosT[i] = __cosf(ang); sinT[i] = __sinf(ang); } }
            for (int it = bx; it < 192; it += G) mods_item(P, it, lds, tid, wave, lane);
            __syncthreads();
            convert_weights(P, 0, lds, gw, ngw, wave, lane);
        } else if (kind == 1) {
            if (l == 0) {
                for (int R = gw; R < MT; R += ngw) { const int bb = R / RB, p = R % RB; const float* md = MODS + (size_t)(p < CTX ? 4 : bb) * 6144;
                    const float* src = p < CTX ? P.ctx + ((size_t)bb * CTX + p) * DM : P.x + ((size_t)bb * SEQ + (p - CTX)) * DM;
                    row_update<0>(src, nullptr, nullptr, nullptr, nullptr, ng, md, md + 1024, Hb + (size_t)R * DM, lane); }
            }
        } else if (kind == 2) {
            SchedWin S{(const char*)(Hb + (size_t)b * RB * DM), (const char*)(Wb + WO_IN / 2), G, bx};
            EpiWin E{Yb, LOGF, VTb, cosT, sinT, P.hgrn_lb, l};
            pg8::gemm_phase(lds, pg8::GemmDesc{DM, DM, DM}, S, E);
        } else if (kind == 3) {
                        for (int it = bx; it < 330; it += G) kmax_item(lds, Yb, (unsigned*)(ws + WS_BAR) + 5120 + (l * NB + b) * 16, it);
            __syncthreads();
#pragma clang loop unroll(disable)
            for (int v = bx; v < 4 * NCH; v += G) hgrn_pass1_unit(lds, Yb, VTb, Gs, DEC, v / NCH, v % NCH);
        } else if (kind == 5) {
            const float* dl = P.diff_lambda + l * 256;
            const float lam_init = l == 0 ? 0.2f : 0.35550906758f;
            const float lam = fexp(wave_sum(dl[lane] * dl[64 + lane])) - fexp(wave_sum(dl[128 + lane] * dl[192 + lane])) + lam_init;
            unsigned* sflag = (unsigned*)(ws + WS_BAR) + 4096 + 64 * (l * NB + b);
            for (int su = G - 1 - bx; su < 128; su += G) {
                hgrn_pass2(Gs, DEC, STb, su * 1024, su * 1024 + 1024, tid);
                asm volatile("s_waitcnt vmcnt(0)" ::: "memory");
                __syncthreads();
                if (tid == 0) { __builtin_amdgcn_fence(__ATOMIC_RELEASE, "agent"); asm volatile("s_waitcnt vmcnt(0)" ::: "memory"); xb_add(sflag, 1u); }
            }
            const int nl = bx < 256 ? (255 - bx) / G + 1 : 0;
#pragma clang loop unroll(disable)
            for (int k = 0; k < nl + 8; ++k) {
                int u; bool lat = true;
                if (k < nl) u = bx + k * G; else { const int v = k - nl; if (l == DEPTH - 1 || (120 + v) % G != bx) continue; u = v; lat = false; }
                const int uu = lat ? ((((u & 7) >> 1) << 6) | ((u & 1) << 5) | (u >> 3)) : u;
                diff_attn_unit(lds, Yb, VTb, YMb, lat ? (uu >> 6) : (uu >> 1), lat ? CTX + 128 * (uu & 63) : 128 * (uu & 1), lat ? RB : CTX, lam, P.diff_subln + l * 128, 1.f - lam_init, (const unsigned*)(ws + WS_BAR) + 5120 + (l * NB + b) * 16);
            }
            {   const int nls = bx < 256 ? (255 - bx) / G + 1 : 0;
#pragma clang loop unroll(disable)
                for (int k = 0; k < nls + 8; ++k) {
                    int u; if (k < nls) u = bx + k * G; else { const int e = k - nls; if (l == DEPTH - 1 || G - 1 - (16 + e) % G != bx) continue; u = 256 + e; }
                    const bool lat = u < 256; const int vv = lat ? u : u - 256;
                    swa_unit(lds, Yb, YMb, lat ? (vv >> 7) : (vv >> 2), lat ? (vv & 127) : (vv & 3), lat, P.swa_sink + l * 8, (const unsigned*)(ws + WS_BAR) + 5120 + (l * NB + b) * 16); } }
            {   if (tid == 0) { unsigned sp = 0; while (xb_ld(sflag) < 128u) { __builtin_amdgcn_s_sleep(2); if (++sp > (1u << 24)) break; }
                    __builtin_amdgcn_fence(__ATOMIC_ACQUIRE, "agent"); asm volatile("s_waitcnt vmcnt(0)" ::: "memory"); }
                __syncthreads(); }
#pragma clang loop unroll(disable)
            for (int v = bx; v < 4 * NCH; v += G) { if (l == DEPTH - 1 && v % NCH < 4) continue; hgrn_pass3_unit(lds, Yb, LOGF, VTb, STb, YMb, P.hgrn_norm + l * 128, v / NCH, v % NCH); }
        } else if (kind == 6) {
            SchedMerge S{(const char*)YMb, (const char*)(Wb + WO_BR / 2), bx, l == DEPTH - 1};
            EpiMerge E{Yb, Gs, MG + (size_t)b * RB * DM};
            pg8::gemm_phase(lds, pg8::GemmDesc{YMW, 512, 512}, S, E);
        } else if (kind == 7) {
            const bool sk = l == DEPTH - 1; SchedPlain S{(const char*)MG, (const char*)(Wb + WO_OUT / 2), sk ? 128 : MT / 256, DM / 256, DM, G, bx, sk};
            EpiStore<1> E{(void*)YOUT, DM};
            pg8::gemm_phase(lds, pg8::GemmDesc{DM, DM, DM}, S, E);
        } else if (kind == 8) {
            for (int R = gw; R < MT; R += ngw) { const int bb = R / RB, p = R % RB; const float* md = MODS + (size_t)(l * 5 + (p < CTX ? 4 : bb)) * 6144;
                if (l == DEPTH - 1 && p < CTX) continue;
                const float* rin; float* rout;
                if (p < CTX) { rout = CTXR + ((size_t)bb * CTX + p) * DM; rin = l == 0 ? P.ctx + ((size_t)bb * CTX + p) * DM : rout; }
                else { rout = P.out + ((size_t)bb * SEQ + (p - CTX)) * DM; rin = l == 0 ? P.x + ((size_t)bb * SEQ + (p - CTX)) * DM : rout; }
                row_update<2>(rin, rout, YOUT + (size_t)R * DM, md + 2048, ng + DM, ng + 2 * DM, md + 3072, md + 4096, Hb + (size_t)R * DM, lane); }
        } else if (kind == 9) {
            const bool sk = l == DEPTH - 1; SchedPlain S{(const char*)Hb, (const char*)(Wb + WO_UP / 2), sk ? 128 : MT / 256, FF / 256, DM, G, bx, sk};
            EpiStore<2> E{(void*)Ub, FF};
            pg8::gemm_phase(lds, pg8::GemmDesc{DM, DM, DM}, S, E);
        } else if (kind == 10) {
            const bool sk = l == DEPTH - 1; SchedPlain S{(const char*)Ub, (const char*)(Wb + WO_DN / 2), sk ? 128 : MT / 256, DM / 256, FF, G, bx, sk};
            EpiStore<1> E{(void*)Zb, DM};
            pg8::gemm_phase(lds, pg8::GemmDesc{FF, FF, FF}, S, E);
        } else {
            const bool more = l + 1 < DEPTH;
            const float* ngn = P.norm_g + (size_t)(more ? l + 1 : l) * 4 * DM;
            for (int R = gw; R < MT; R += ngw) { const int bb = R / RB, p = R % RB; const int vsel = p < CTX ? 4 : bb; const float* md = MODS + (size_t)(l * 5 + vsel) * 6144;
                if (!more && p < CTX) continue;
                float* rr = p < CTX ? CTXR + ((size_t)bb * CTX + p) * DM : P.out + ((size_t)bb * SEQ + (p - CTX)) * DM;
                const float* mdn = MODS + (size_t)((more ? l + 1 : l) * 5 + vsel) * 6144;
                row_update<2>(rr, rr, Zb + (size_t)R * DM, md + 5120, ng + 3 * DM, ngn, mdn, mdn + 1024, more ? Hb + (size_t)R * DM : nullptr, lane); }
            if (more) { __syncthreads(); convert_weights(P, l + 1, lds, gw, ngw, wave, lane); }
        }
        if (ph + 1 < hi) { if (hi < 0) grid.sync(); else xcd_barrier(xbar); }
    }
}

extern "C" void kernel_launch(void* const* d_in, const int* in_sizes, int n_in, void* d_out, int out_size, void* d_ws, size_t ws_size, hipStream_t stream) {
    static int grid = 0;
    if (grid == 0) {
        if (n_in != 17 || ws_size < WS_END) { fprintf(stderr, "kernel_launch: unexpected inputs (n_in %d, ws %zu, need %zu)\n", n_in, ws_size, (size_t)WS_END); grid = -1; return; }
        int dev = 0, cus = 0, per_cu = 0;
        hipGetDevice(&dev); hipDeviceGetAttribute(&cus, hipDeviceAttributeMultiprocessorCount, dev);
        hipFuncSetAttribute((const void*)fwd_kernel, hipFuncAttributeMaxDynamicSharedMemorySize, LDS_BYTES);
        hipOccupancyMaxActiveBlocksPerMultiprocessor(&per_cu, (const void*)fwd_kernel, NTHR, LDS_BYTES);
        if (per_cu < 1) per_cu = 1;
        (void)hipGetLastError();
        grid = cus * 1;
        if (grid > 256) grid = 256;
    }
    if (grid < 0) return;
    Args a{};
    const float** pp = (const float**)&a.P;
    for (int i = 0; i < 17; ++i) pp[i] = (const float*)d_in[i];
    a.P.out = (float*)d_out; a.P.ws = (unsigned char*)d_ws;
    (void)hipMemsetAsync((char*)d_ws + WS_BAR, 0, 32768, stream);
#if MK_ONE_LAUNCH
    a.ph_lo = 0; a.ph_hi = N_PHASES;
    void* kargs[] = {&a};
    hipError_t e = hipLaunchCooperativeKernel((const void*)fwd_kernel, dim3(grid), dim3(NTHR), kargs, LDS_BYTES, stream);
    if (e != hipSuccess) fprintf(stderr, "cooperative launch failed: %s (grid %d)\n", hipGetErrorString(e), grid);
#else
    for (int p = 0; p < N_PHASES; ++p) { a.ph_lo = p; a.ph_hi = p + 1; hipLaunchKernelGGL(fwd_kernel, dim3(grid), dim3(NTHR), LDS_BYTES, stream, a); }
#endif
}
```
